# Optimizing an MI355X kernel written in HIP

```python
import math, functools
import jax, jax.numpy as jnp
from jax import lax
import numpy as np

D_MODEL = 1024
BATCH = 4
SEQ = 8192
DEPTH = 4

CONV_CH = 512
N_HEADS = 8
HEAD_DIM = 64
ATTN_CH = N_HEADS * HEAD_DIM
D_MIX = CONV_CH + ATTN_CH
D_IN = 2 * CONV_CH + 3 * ATTN_CH
CONV_K = 31
GRID_W = 64
WIN_R = 8
WIN_C = 16
Q_CB = 16
N_CB = GRID_W // Q_CB
BAND_C = Q_CB + WIN_C
D_FF = 2816
N_EXPERTS = 8
TOP_K = 2
D_FF_EXPERT = 3584
MOE_BLK = 128
N_DENSE = (DEPTH + 1) // 2
N_MOE = DEPTH // 2
D_PLE = 256
LN_EPS = 1e-5
DEEPNORM_ALPHA = (2.0 * DEPTH) ** 0.25
DEEPNORM_BETA = (8.0 * DEPTH) ** -0.25

kernel_name = "hybrid_conformer_natten_moe_deepnorm_encoder"


def layer_norm(x, g, b):
    xf = x.astype(jnp.float32)
    mu = jnp.mean(xf, axis=-1, keepdims=True)
    xc = xf - mu
    var = jnp.mean(xc * xc, axis=-1, keepdims=True)
    y = xc * lax.rsqrt(var + LN_EPS)
    return (y * g.astype(jnp.float32) + b.astype(jnp.float32)).astype(x.dtype)


def conformer_conv(a, g, w, b, ln_g, ln_b):
    u = a * jax.nn.sigmoid(g)
    c = u.shape[-1]
    pad = CONV_K // 2
    y = lax.conv_general_dilated(
        u, w[:, None, :], window_strides=(1,), padding=[(pad, pad)],
        dimension_numbers=("NWC", "WIO", "NWC"), feature_group_count=c)
    y = layer_norm(y + b, ln_g, ln_b)
    return jax.nn.silu(y)


def neighbourhood_attention(q, k, v, rpb):
    B, T, H, Dh = q.shape
    rows = T // GRID_W
    kr = min(WIN_R, rows)
    scale = Dh ** -0.5
    band0 = np.clip(np.arange(N_CB) * Q_CB - WIN_C // 2, 0, GRID_W - BAND_C)
    key_col = band0[:, None] + np.arange(BAND_C)
    q_col = np.arange(GRID_W).reshape(N_CB, Q_CB)
    win0 = np.clip(q_col - WIN_C // 2, 0, GRID_W - WIN_C)
    col_mask = ((key_col[:, None, :] >= win0[:, :, None]) &
                (key_col[:, None, :] < win0[:, :, None] + WIN_C))
    dc_idx = np.clip(key_col[:, None, :] - q_col[:, :, None] + WIN_C - 1, 0, 2 * WIN_C - 2)
    rpb_c = rpb[:, :, dc_idx]
    kg = k.reshape(B, rows, GRID_W, H, Dh)
    vg = v.reshape(B, rows, GRID_W, H, Dh)
    qr = jnp.moveaxis(q.reshape(B, rows, N_CB, Q_CB, H, Dh), 1, 0)

    def row_fn(args):
        r, q_row = args
        r0 = jnp.clip(r - kr // 2, 0, rows - kr)
        k_band = lax.dynamic_slice_in_dim(kg, r0, kr, axis=1)[:, :, key_col]
        v_band = lax.dynamic_slice_in_dim(vg, r0, kr, axis=1)[:, :, key_col]
        s = jnp.einsum("bjqhd,bijkhd->bhjqik", q_row, k_band).astype(jnp.float32) * scale
        dr_idx = r0 + jnp.arange(kr) - r + WIN_R - 1
        bias = jnp.transpose(jnp.take(rpb_c, dr_idx, axis=1), (0, 2, 3, 1, 4))
        s = jnp.where(col_mask[:, :, None, :], s + bias.astype(jnp.float32), -jnp.inf)
        w = jax.nn.softmax(s.reshape(B, H, N_CB, Q_CB, kr * BAND_C), axis=-1)
        w = w.reshape(s.shape).astype(v.dtype)
        return jnp.einsum("bhjqik,bijkhd->bjqhd", w, v_band)

    out = lax.map(row_fn, (jnp.arange(rows), qr))
    return jnp.moveaxis(out, 0, 1).reshape(B, T, H * Dh)


def swiglu(x, w1, w3, w2):
    return (jax.nn.silu(x @ w1) * (x @ w3)) @ w2


def moe_swiglu(x, w_router, w1, w3, w2):
    B, T, D = x.shape
    xf = x.reshape(-1, D)
    n = xf.shape[0]
    logits = (xf @ w_router).astype(jnp.float32)
    top_vals, top_idx = lax.top_k(logits, TOP_K)
    gates = jax.nn.softmax(top_vals, axis=-1)
    n_assign = n * TOP_K
    e_flat = top_idx.reshape(-1)
    tok_flat = jnp.repeat(jnp.arange(n, dtype=jnp.int32), TOP_K)
    g_flat = gates.reshape(-1)
    order = jnp.argsort(e_flat)
    e_sorted = e_flat[order]
    tok_sorted = tok_flat[order]
    g_sorted = g_flat[order]
    counts = jnp.bincount(e_flat, length=N_EXPERTS)
    starts = jnp.cumsum(counts) - counts
    padded = (counts + MOE_BLK - 1) // MOE_BLK * MOE_BLK
    pends = jnp.cumsum(padded)
    pstarts = pends - padded
    dest = pstarts[e_sorted] + (jnp.arange(n_assign) - starts[e_sorted])
    n_blocks = -(-n_assign // MOE_BLK) + N_EXPERTS
    n_slots = n_blocks * MOE_BLK
    tok_buf = jnp.zeros((n_slots,), jnp.int32).at[dest].set(tok_sorted)
    gate_buf = jnp.zeros((n_slots,), jnp.float32).at[dest].set(g_sorted)
    block_e = jnp.minimum(
        jnp.searchsorted(pends, jnp.arange(n_blocks) * MOE_BLK, side="right"), N_EXPERTS - 1)

    def block_fn(args):
        tok, e = args
        xb = xf[tok]
        return (jax.nn.silu(xb @ w1[e]) * (xb @ w3[e])) @ w2[e]

    y = lax.map(block_fn, (tok_buf.reshape(n_blocks, MOE_BLK), block_e)).reshape(n_slots, D)
    y = y * gate_buf[:, None].astype(y.dtype)
    out = jax.ops.segment_sum(y, tok_buf, num_segments=n)
    return out.reshape(B, T, D)


def setup_inputs(seed: int = 0) -> dict:
    key = jax.random.key(seed)
    ks = jax.random.split(key, 32)
    f32 = jnp.float32
    nrm = lambda k, shape, s: jax.random.normal(k, shape, f32) * s
    gain = lambda k, shape: 1.0 + 0.02 * jax.random.normal(k, shape, f32)
    return {
        "x": jax.random.normal(ks[0], (BATCH, SEQ, D_MODEL), f32),
        "p": jax.random.normal(ks[1], (DEPTH, BATCH, SEQ, D_PLE), f32),
        "ln_in_g": gain(ks[2], (D_MODEL,)),
        "ln_in_b": nrm(ks[3], (D_MODEL,), 0.02),
        "w_in": nrm(ks[4], (DEPTH, D_MODEL, D_IN), D_MODEL ** -0.5),
        "b_in": nrm(ks[5], (DEPTH, D_IN), 0.02),
        "conv_w": nrm(ks[6], (DEPTH, CONV_K, CONV_CH), CONV_K ** -0.5),
        "conv_b": nrm(ks[7], (DEPTH, CONV_CH), 0.02),
        "conv_ln_g": gain(ks[8], (DEPTH, CONV_CH)),
        "conv_ln_b": nrm(ks[9], (DEPTH, CONV_CH), 0.02),
        "rpb": nrm(ks[10], (DEPTH, N_HEADS, 2 * WIN_R - 1, 2 * WIN_C - 1), 0.02),
        "w_out": nrm(ks[11], (DEPTH, D_MIX, D_MODEL), D_MIX ** -0.5 * DEEPNORM_BETA),
        "b_out": nrm(ks[12], (DEPTH, D_MODEL), 0.02),
        "ln1_g": gain(ks[13], (DEPTH, D_MODEL)),
        "ln1_b": nrm(ks[14], (DEPTH, D_MODEL), 0.02),
        "ffn_w1": nrm(ks[15], (N_DENSE, D_MODEL, D_FF), D_MODEL ** -0.5),
        "ffn_w3": nrm(ks[16], (N_DENSE, D_MODEL, D_FF), D_MODEL ** -0.5),
        "ffn_w2": nrm(ks[17], (N_DENSE, D_FF, D_MODEL), D_FF ** -0.5 * DEEPNORM_BETA),
        "w_router": nrm(ks[18], (N_MOE, D_MODEL, N_EXPERTS), D_MODEL ** -0.5),
        "moe_w1": nrm(ks[19], (N_MOE, N_EXPERTS, D_MODEL, D_FF_EXPERT), D_MODEL ** -0.5),
        "moe_w3": nrm(ks[20], (N_MOE, N_EXPERTS, D_MODEL, D_FF_EXPERT), D_MODEL ** -0.5),
        "moe_w2": nrm(ks[21], (N_MOE, N_EXPERTS, D_FF_EXPERT, D_MODEL), D_FF_EXPERT ** -0.5 * DEEPNORM_BETA),
        "ple_w": nrm(ks[22], (DEPTH, D_PLE, D_MODEL), D_PLE ** -0.5 * DEEPNORM_BETA),
        "ple_gate_w": nrm(ks[23], (DEPTH, D_MODEL, D_MODEL), D_MODEL ** -0.5),
        "ple_gate_b": nrm(ks[24], (DEPTH, D_MODEL), 0.02),
        "ln2_g": gain(ks[25], (DEPTH, D_MODEL)),
        "ln2_b": nrm(ks[26], (DEPTH, D_MODEL), 0.02),
    }


def reference(x, p, ln_in_g, ln_in_b, w_in, b_in, conv_w, conv_b, conv_ln_g, conv_ln_b,
              rpb, w_out, b_out, ln1_g, ln1_b, ffn_w1, ffn_w3, ffn_w2, w_router,
              moe_w1, moe_w3, moe_w2, ple_w, ple_gate_w, ple_gate_b, ln2_g, ln2_b):
    B, T, _ = x.shape
    h = layer_norm(x, ln_in_g, ln_in_b)
    for i in range(DEPTH):
        proj = h @ w_in[i] + b_in[i]
        a = proj[..., :CONV_CH]
        g = proj[..., CONV_CH:2 * CONV_CH]
        qkv = proj[..., 2 * CONV_CH:].reshape(B, T, 3, N_HEADS, HEAD_DIM)
        conv_out = conformer_conv(a, g, conv_w[i], conv_b[i], conv_ln_g[i], conv_ln_b[i])
        attn_out = neighbourhood_attention(qkv[:, :, 0], qkv[:, :, 1], qkv[:, :, 2], rpb[i])
        mix = jnp.concatenate([conv_out, attn_out], axis=-1) @ w_out[i] + b_out[i]
        h = layer_norm(DEEPNORM_ALPHA * h + mix, ln1_g[i], ln1_b[i])
        j = i // 2
        if i % 2 == 0:
            f = swiglu(h, ffn_w1[j], ffn_w3[j], ffn_w2[j])
        else:
            f = moe_swiglu(h, w_router[j], moe_w1[j], moe_w3[j], moe_w2[j])
        e = jax.nn.sigmoid(h @ ple_gate_w[i] + ple_gate_b[i]) * (p[i] @ ple_w[i])
        h = layer_norm(DEEPNORM_ALPHA * h + f + e, ln2_g[i], ln2_b[i])
    return h
```

```cpp
#include <hip/hip_runtime.h>
#include <cstdio>
#include <cstdint>

namespace v0 {
constexpr int D = 1024, BATCH = 4, SEQ = 8192, DEPTH = 4, M = BATCH * SEQ;
constexpr int CONV_CH = 512, NH = 8, HD = 64, DIN = 2560, CONV_K = 31, GRID_W = 64, ROWS = SEQ / GRID_W;
constexpr int DFF = 2816, NE = 8, DFE = 3584, DPLE = 256;
constexpr float LN_EPS = 1e-5f;
constexpr float ALPHA = 1.681792830507429f;

__device__ __forceinline__ float wave_sum(float v) {
#pragma unroll
    for (int o = 1; o < 64; o <<= 1) v += __shfl_xor(v, o);
    return v;
}
__device__ __forceinline__ float sigmoidf_(float x) { return 1.f / (1.f + __expf(-x)); }

template <int NV, bool SILU>
__global__ void __launch_bounds__(256) k_ln(const float* in, int ldi, const float* g, const float* b, float* out, int ldo, int rows) {
    const int lane = threadIdx.x & 63, w = (blockIdx.x * 256 + threadIdx.x) >> 6;
    if (w >= rows) return;
    const float* r = in + (size_t)w * ldi;
    float v[NV]; float s = 0.f;
#pragma unroll
    for (int j = 0; j < NV; ++j) { v[j] = r[lane + 64 * j]; s += v[j]; }
    const float mean = wave_sum(s) / (64.f * NV); float q = 0.f;
#pragma unroll
    for (int j = 0; j < NV; ++j) { v[j] -= mean; q += v[j] * v[j]; }
    const float rstd = 1.f / sqrtf(wave_sum(q) / (64.f * NV) + LN_EPS);
    float* o = out + (size_t)w * ldo;
#pragma unroll
    for (int j = 0; j < NV; ++j) { float y = v[j] * rstd * g[lane + 64 * j] + b[lane + 64 * j]; if (SILU) y = y * sigmoidf_(y); o[lane + 64 * j] = y; }
}

template <int EPI>
__global__ void __launch_bounds__(256) k_gemm(const float* A, int lda, const float* B, int ldb, float* C, int ldc, int K,
                                              const float* bias, const float* aux, float alpha, const int* list, const int* cntp, int e) {
    __shared__ float As[16][132];
    __shared__ float Bs[16][132];
    const int tid = threadIdx.x, tx = tid & 15, ty = tid >> 4;
    const int m0 = blockIdx.y * 128, n0 = blockIdx.x * 128;
    int cnt = 0x7fffffff;
    if (list) { cnt = cntp[e]; if (m0 >= cnt) return; }
    float acc[8][8];
#pragma unroll
    for (int i = 0; i < 8; ++i)
#pragma unroll
        for (int j = 0; j < 8; ++j) acc[i][j] = 0.f;
    const int ar = tid >> 2, ac = (tid & 3) * 4;
    size_t arow[2];
#pragma unroll
    for (int i = 0; i < 2; ++i) {
        int r = m0 + ar + 64 * i;
        if (list) { int rr = r < cnt ? r : cnt - 1; r = (EPI == 6) ? rr : list[rr]; }
        arow[i] = (size_t)r * lda;
    }
    const int br = tid >> 5, bc = (tid & 31) * 4;
    for (int k0 = 0; k0 < K; k0 += 16) {
#pragma unroll
        for (int i = 0; i < 2; ++i) {
            const float4 a = *(const float4*)(A + arow[i] + k0 + ac);
            As[ac + 0][ar + 64 * i] = a.x; As[ac + 1][ar + 64 * i] = a.y; As[ac + 2][ar + 64 * i] = a.z; As[ac + 3][ar + 64 * i] = a.w;
        }
#pragma unroll
        for (int i = 0; i < 2; ++i) {
            const float4 b = *(const float4*)(B + (size_t)(k0 + br + 8 * i) * ldb + n0 + bc);
            *(float4*)&Bs[br + 8 * i][bc] = b;
        }
        __syncthreads();
#pragma unroll
        for (int k = 0; k < 16; ++k) {
            float a[8], b[8];
#pragma unroll
            for (int i = 0; i < 8; ++i) a[i] = As[k][ty * 8 + i];
#pragma unroll
            for (int j = 0; j < 8; ++j) b[j] = Bs[k][tx * 8 + j];
#pragma unroll
            for (int i = 0; i < 8; ++i)
#pragma unroll
                for (int j = 0; j < 8; ++j) acc[i][j] += a[i] * b[j];
        }
        __syncthreads();
    }
#pragma unroll
    for (int i = 0; i < 8; ++i) {
        const int r = m0 + ty * 8 + i;
        if (list && r >= cnt) continue;
        int orow = r; float gate = 0.f;
        if (EPI == 6) { orow = list[r]; gate = aux[(size_t)orow * 8 + e]; }
        float* crow = C + (size_t)orow * ldc + n0 + tx * 8;
#pragma unroll
        for (int j = 0; j < 8; ++j) {
            const int col = n0 + tx * 8 + j; const float v = acc[i][j];
            if (EPI == 0) crow[j] = v + (bias ? bias[col] : 0.f);
            else if (EPI == 1) crow[j] = alpha * crow[j] + v + bias[col];
            else if (EPI == 2) { const float c = crow[j]; crow[j] = c * sigmoidf_(c) * v; }
            else if (EPI == 3) crow[j] = alpha * crow[j] + sigmoidf_(v + bias[col]) * aux[(size_t)r * ldc + col];
            else if (EPI == 4) crow[j] += v;
            else if (EPI == 5) crow[j] = v;
            else if (EPI == 6) crow[j] += gate * v;
        }
    }
}

__global__ void __launch_bounds__(256) k_glu(const float* proj, float* U) {
    const size_t i = (size_t)blockIdx.x * 256 + threadIdx.x;
    const size_t t = i / CONV_CH; const int c = (int)(i % CONV_CH);
    const float a = proj[t * DIN + c], g = proj[t * DIN + CONV_CH + c];
    U[i] = a * sigmoidf_(g);
}
__global__ void __launch_bounds__(256) k_dwconv(const float* U, const float* w, const float* b, float* Y) {
    const size_t i = (size_t)blockIdx.x * 256 + threadIdx.x;
    const int t = (int)(i / CONV_CH), c = (int)(i % CONV_CH);
    const int bt = t / SEQ, tt = t % SEQ;
    float s = b[c];
    for (int k = 0; k < CONV_K; ++k) { const int ts = tt + k - CONV_K / 2; if (ts >= 0 && ts < SEQ) s += w[k * CONV_CH + c] * U[((size_t)bt * SEQ + ts) * CONV_CH + c]; }
    Y[i] = s;
}
__global__ void __launch_bounds__(256) k_attn(const float* proj, const float* rpb, float* mix) {
    const int lane = threadIdx.x & 63; const int w = (blockIdx.x * 256 + threadIdx.x) >> 6;
    const int t = w / NH, h = w % NH;
    const int bt = t / SEQ, tt = t % SEQ, r = tt / GRID_W, c = tt % GRID_W;
    int r0 = r - 4; r0 = r0 < 0 ? 0 : (r0 > ROWS - 8 ? ROWS - 8 : r0);
    int c0 = c - 8; c0 = c0 < 0 ? 0 : (c0 > GRID_W - 16 ? GRID_W - 16 : c0);
    const float q = proj[(size_t)t * DIN + 1024 + h * HD + lane];
    float mx = -INFINITY, l = 0.f, acc = 0.f;
    for (int i = 0; i < 8; ++i)
        for (int j = 0; j < 16; ++j) {
            const int kr = r0 + i, kc = c0 + j; const size_t kt = (size_t)bt * SEQ + kr * GRID_W + kc;
            const float kv = proj[kt * DIN + 1536 + h * HD + lane], vv = proj[kt * DIN + 2048 + h * HD + lane];
            float s = wave_sum(q * kv) * 0.125f + rpb[(h * 15 + (kr - r + 7)) * 31 + (kc - c + 15)];
            const float nm = fmaxf(mx, s), f = __expf(mx - nm), p = __expf(s - nm);
            l = l * f + p; acc = acc * f + p * vv; mx = nm;
        }
    mix[(size_t)t * D + CONV_CH + h * HD + lane] = acc / l;
}
__global__ void __launch_bounds__(256) k_router(const float* h, const float* wr, float* gates, int* top) {
    const int lane = threadIdx.x & 63; const int t = (blockIdx.x * 256 + threadIdx.x) >> 6;
    float lg[NE];
#pragma unroll
    for (int e = 0; e < NE; ++e) lg[e] = 0.f;
    for (int j = 0; j < 16; ++j) { const int d = lane + 64 * j; const float x = h[(size_t)t * D + d];
#pragma unroll
        for (int e = 0; e < NE; ++e) lg[e] += x * wr[d * NE + e]; }
#pragma unroll
    for (int e = 0; e < NE; ++e) lg[e] = wave_sum(lg[e]);
    int i0 = 0; float v0 = lg[0];
#pragma unroll
    for (int e = 1; e < NE; ++e) if (lg[e] > v0) { v0 = lg[e]; i0 = e; }
    int i1 = -1; float v1 = -INFINITY;
#pragma unroll
    for (int e = 0; e < NE; ++e) if (e != i0 && lg[e] > v1) { v1 = lg[e]; i1 = e; }
    const float g1 = 1.f / (1.f + __expf(v0 - v1)), g0 = 1.f - g1;
    if (lane < NE) gates[(size_t)t * NE + lane] = lane == i0 ? g0 : (lane == i1 ? g1 : 0.f);
    if (lane == 0) { top[2 * t] = i0; top[2 * t + 1] = i1; }
}
__global__ void __launch_bounds__(64) k_lists(const int* top, int* list, int* cnt) {
    const int e = blockIdx.x, lane = threadIdx.x; int n = 0;
    for (int t0 = 0; t0 < M; t0 += 64) { const int t = t0 + lane; const bool sel = top[2 * t] == e || top[2 * t + 1] == e;
        const unsigned long long m = __ballot(sel); if (sel) list[(size_t)e * M + n + __popcll(m & ((1ull << lane) - 1ull))] = t; n += __popcll(m); }
    if (lane == 0) cnt[e] = n;
}
}

extern "C" void kernel_launch(void* const* d_in, const int* in_sizes, int n_in, void* d_out, int out_size, void* d_ws, size_t ws_size, hipStream_t stream) {
    using namespace v0;
    const float* x = (const float*)d_in[0]; const float* p = (const float*)d_in[1];
    const float* ln_in_g = (const float*)d_in[2]; const float* ln_in_b = (const float*)d_in[3];
    const float* w_in = (const float*)d_in[4]; const float* b_in = (const float*)d_in[5];
    const float* conv_w = (const float*)d_in[6]; const float* conv_b = (const float*)d_in[7];
    const float* conv_ln_g = (const float*)d_in[8]; const float* conv_ln_b = (const float*)d_in[9];
    const float* rpb = (const float*)d_in[10]; const float* w_out = (const float*)d_in[11]; const float* b_out = (const float*)d_in[12];
    const float* ln1_g = (const float*)d_in[13]; const float* ln1_b = (const float*)d_in[14];
    const float* ffn_w1 = (const float*)d_in[15]; const float* ffn_w3 = (const float*)d_in[16]; const float* ffn_w2 = (const float*)d_in[17];
    const float* w_router = (const float*)d_in[18];
    const float* moe_w1 = (const float*)d_in[19]; const float* moe_w3 = (const float*)d_in[20]; const float* moe_w2 = (const float*)d_in[21];
    const float* ple_w = (const float*)d_in[22]; const float* ple_gate_w = (const float*)d_in[23]; const float* ple_gate_b = (const float*)d_in[24];
    const float* ln2_g = (const float*)d_in[25]; const float* ln2_b = (const float*)d_in[26];
    constexpr size_t MiB = 1u << 20;
    char* ws = (char*)d_ws;
    float* H = (float*)(ws + 0);
    float* R = (float*)(ws + 128 * MiB);
    float* PROJ = R; float* MIXIN = R + (size_t)M * DIN; float* ACT = R;
    float* PE = (float*)(ws + 576 * MiB);
    float* U = (float*)(ws + 704 * MiB);
    float* Y = (float*)(ws + 768 * MiB);
    float* GATES = (float*)(ws + 832 * MiB);
    int* TOP = (int*)(ws + 833 * MiB);
    int* LIST = (int*)(ws + 834 * MiB);
    int* CNT = (int*)(ws + 835 * MiB);
    if (ws_size < 836 * MiB) { fprintf(stderr, "ws too small\n"); return; }
    float* OUT = (float*)d_out;

    k_ln<16, false><<<M / 4, 256, 0, stream>>>(x, D, ln_in_g, ln_in_b, H, D, M);
    for (int i = 0; i < DEPTH; ++i) {
        const int j = i / 2;
        k_gemm<0><<<dim3(DIN / 128, M / 128), 256, 0, stream>>>(H, D, w_in + (size_t)i * D * DIN, DIN, PROJ, DIN, D, b_in + i * DIN, nullptr, 0.f, nullptr, nullptr, 0);
        k_glu<<<M * CONV_CH / 256, 256, 0, stream>>>(PROJ, U);
        k_dwconv<<<M * CONV_CH / 256, 256, 0, stream>>>(U, conv_w + i * CONV_K * CONV_CH, conv_b + i * CONV_CH, Y);
        k_ln<8, true><<<M / 4, 256, 0, stream>>>(Y, CONV_CH, conv_ln_g + i * CONV_CH, conv_ln_b + i * CONV_CH, MIXIN, D, M);
        k_attn<<<M * NH / 4, 256, 0, stream>>>(PROJ, rpb + i * NH * 15 * 31, MIXIN);
        k_gemm<1><<<dim3(D / 128, M / 128), 256, 0, stream>>>(MIXIN, D, w_out + (size_t)i * D * D, D, H, D, D, b_out + i * D, nullptr, ALPHA, nullptr, nullptr, 0);
        k_ln<16, false><<<M / 4, 256, 0, stream>>>(H, D, ln1_g + i * D, ln1_b + i * D, H, D, M);
        k_gemm<0><<<dim3(D / 128, M / 128), 256, 0, stream>>>(p + (size_t)i * M * DPLE, DPLE, ple_w + (size_t)i * DPLE * D, D, PE, D, DPLE, nullptr, nullptr, 0.f, nullptr, nullptr, 0);
        if (i % 2 == 0) {
            k_gemm<0><<<dim3(DFF / 128, M / 128), 256, 0, stream>>>(H, D, ffn_w1 + (size_t)j * D * DFF, DFF, ACT, DFF, D, nullptr, nullptr, 0.f, nullptr, nullptr, 0);
            k_gemm<2><<<dim3(DFF / 128, M / 128), 256, 0, stream>>>(H, D, ffn_w3 + (size_t)j * D * DFF, DFF, ACT, DFF, D, nullptr, nullptr, 0.f, nullptr, nullptr, 0);
            float* TMP = U;
            (void)hipMemcpyAsync(TMP, H, (size_t)M * D * 4, hipMemcpyDeviceToDevice, stream);
            k_gemm<3><<<dim3(D / 128, M / 128), 256, 0, stream>>>(H, D, ple_gate_w + (size_t)i * D * D, D, TMP, D, D, ple_gate_b + i * D, PE, ALPHA, nullptr, nullptr, 0);
            k_gemm<4><<<dim3(D / 128, M / 128), 256, 0, stream>>>(ACT, DFF, ffn_w2 + (size_t)j * DFF * D, D, TMP, D, DFF, nullptr, nullptr, 0.f, nullptr, nullptr, 0);
            k_ln<16, false><<<M / 4, 256, 0, stream>>>(TMP, D, ln2_g + i * D, ln2_b + i * D, (i == DEPTH - 1) ? OUT : H, D, M);
        } else {
            k_router<<<M / 4, 256, 0, stream>>>(H, w_router + (size_t)j * D * NE, GATES, TOP);
            k_lists<<<NE, 64, 0, stream>>>(TOP, LIST, CNT);
            float* TMP = U;
            (void)hipMemcpyAsync(TMP, H, (size_t)M * D * 4, hipMemcpyDeviceToDevice, stream);
            k_gemm<3><<<dim3(D / 128, M / 128), 256, 0, stream>>>(H, D, ple_gate_w + (size_t)i * D * D, D, TMP, D, D, ple_gate_b + i * D, PE, ALPHA, nullptr, nullptr, 0);
            for (int e = 0; e < NE; ++e) {
                const size_t wo = ((size_t)j * NE + e) * D * DFE;
                k_gemm<5><<<dim3(DFE / 128, M / 128), 256, 0, stream>>>(H, D, moe_w1 + wo, DFE, ACT, DFE, D, nullptr, nullptr, 0.f, LIST + (size_t)e * M, CNT, e);
                k_gemm<2><<<dim3(DFE / 128, M / 128), 256, 0, stream>>>(H, D, moe_w3 + wo, DFE, ACT, DFE, D, nullptr, nullptr, 0.f, LIST + (size_t)e * M, CNT, e);
                k_gemm<6><<<dim3(D / 128, M / 128), 256, 0, stream>>>(ACT, DFE, moe_w2 + wo, D, TMP, D, DFE, nullptr, GATES, 0.f, LIST + (size_t)e * M, CNT, e);
            }
            k_ln<16, false><<<M / 4, 256, 0, stream>>>(TMP, D, ln2_g + i * D, ln2_b + i * D, (i == DEPTH - 1) ? OUT : H, D, M);
        }
    }
}
```

```cpp
#include <hip/hip_runtime.h>
#include <cstdio>
#include <cstdint>

#ifndef MK_MULTI
#define MK_MULTI 0
#endif

#define GAS __attribute__((address_space(1)))
#define LAS __attribute__((address_space(3)))
typedef unsigned short bf16_t;
typedef short bf16x8 __attribute__((ext_vector_type(8)));
typedef float f32x4 __attribute__((ext_vector_type(4)));
typedef float f32x2 __attribute__((ext_vector_type(2)));
typedef unsigned u32x4 __attribute__((ext_vector_type(4)));
typedef unsigned u32x2 __attribute__((ext_vector_type(2)));
typedef GAS unsigned gu32;

constexpr int D = 1024, BATCH = 4, SEQ = 8192, DEPTH = 4, M = BATCH * SEQ;
constexpr int CONV_CH = 512, NH = 8, HD = 64, DIN = 2560, CONV_K = 31, GRID_W = 64, ROWS = SEQ / GRID_W;
constexpr int DFF = 2816, NE = 8, DFE = 3584, DPLE = 256;
constexpr float LN_EPS = 1e-5f;
constexpr float ALPHA = 1.681792830507429f;
constexpr float LOG2E = 1.4426950408889634f;
constexpr float QSCALE = 0.125f * LOG2E;
constexpr int NWAVES = 8;
constexpr int GRID = 256;
constexpr int MAXT = 263;

constexpr size_t MiB = 1u << 20;
constexpr size_t WS_CTL = 0, CTL_ZERO_BYTES = 1 * MiB;
constexpr size_t WS_TOKE = 1 * MiB;
constexpr size_t WS_TOKS = WS_TOKE + 128 * 1024;
constexpr size_t WS_TOKG = WS_TOKS + 256 * 1024;
constexpr size_t WS_LIST = 2 * MiB;
constexpr size_t WS_H32 = 4 * MiB;
constexpr size_t WS_HB = 132 * MiB;
constexpr size_t WS_PE = 196 * MiB;
constexpr size_t WS_Y = WS_PE;
constexpr size_t WS_PBL = 328 * MiB;
constexpr size_t WS_ACT = 344 * MiB;
constexpr size_t WS_AG = WS_ACT;
constexpr size_t WS_Q = WS_AG + 64 * MiB;
constexpr size_t WS_K = WS_Q + 32 * MiB;
constexpr size_t WS_V = WS_K + 32 * MiB;
constexpr size_t WS_MIX = WS_V + 32 * MiB;
constexpr size_t WS_WM = 805 * MiB;
constexpr size_t WM13_E = (size_t)2 * DFE * D * 2, WM2_E = (size_t)D * DFE * 2;
constexpr size_t WS_WM2 = WS_WM + 8 * WM13_E;
constexpr size_t WS_WS = 973 * MiB;
constexpr size_t WS_WIN = WS_WS;
constexpr size_t WS_WOUT = WS_WIN + 4 * (size_t)DIN * D * 2;
constexpr size_t WS_WG = WS_WOUT + 4 * (size_t)D * D * 2;
constexpr size_t WS_WP = WS_WG + 4 * (size_t)D * D * 2;
constexpr size_t WS_W13 = WS_WP + 4 * (size_t)D * DPLE * 2;
constexpr size_t WS_W2 = WS_W13 + 2 * (size_t)2 * DFF * D * 2;
constexpr size_t WS_END = WS_W2 + 2 * (size_t)D * DFF * 2;
static_assert(WS_ACT + (size_t)MAXT * 256 * DFE * 2 <= WS_WM && WS_Y + (size_t)MAXT * 256 * D * 2 <= WS_PBL && WS_MIX + 64 * MiB <= WS_WM && WS_WM2 + 8 * WM2_E <= WS_WS && WS_END <= 1044 * MiB, "d_ws map");
constexpr int CW_TMO = 0, CW_CODE = 1;
constexpr int CW_BAR = 4096;
constexpr int CW_CNT = 8192;

constexpr int RING_BYTES = 131072;
constexpr int TOK_OFF = RING_BYTES;
constexpr int TOK_BYTES = 32 * 512;
constexpr int MISC_OFF = TOK_OFF + TOK_BYTES;
constexpr int LDS_BYTES = MISC_OFF + 256;
static_assert(LDS_BYTES <= 160 * 1024, "LDS");

#define RLX_AGENT __ATOMIC_RELAXED, __HIP_MEMORY_SCOPE_AGENT
#define LDS_WAIT() asm volatile("s_waitcnt lgkmcnt(0)" ::: "memory")
#define VM_WAIT() asm volatile("s_waitcnt vmcnt(0)" ::: "memory")
__device__ __forceinline__ unsigned cvt_pk_bf16(float lo, float hi) { unsigned r; asm volatile("v_cvt_pk_bf16_f32 %0, %1, %2" : "=v"(r) : "v"(lo), "v"(hi)); return r; }
__device__ __forceinline__ float bf_lo(unsigned u) { return __uint_as_float(u << 16); }
__device__ __forceinline__ float bf_hi(unsigned u) { return __uint_as_float(u & 0xffff0000u); }
__device__ __forceinline__ float bf2f(bf16_t u) { return __uint_as_float((unsigned)u << 16); }
template <int X> __device__ __forceinline__ float swz_xor(float v) { return __int_as_float(__builtin_amdgcn_ds_swizzle(__float_as_int(v), (X << 10) | 0x1f)); }
__device__ __forceinline__ float xor32(float v) { auto r = __builtin_amdgcn_permlane32_swap(__float_as_uint(v), __float_as_uint(v), false, false); return __uint_as_float(r[0]) + __uint_as_float(r[1]); }
__device__ __forceinline__ float wave_sum(float v) {
    v += swz_xor<1>(v); v += swz_xor<2>(v); v += swz_xor<4>(v); v += swz_xor<8>(v); v += swz_xor<16>(v);
    return xor32(v);
}
template <int ID> __device__ __forceinline__ int opaque_lane() { int l; asm volatile("; opaque lane %c1\n\tv_mbcnt_lo_u32_b32 %0, -1, 0\n\tv_mbcnt_hi_u32_b32 %0, -1, %0" : "=v"(l) : "i"(ID)); return l; }
#define OPAQUE_LANE() opaque_lane<__COUNTER__>()
template <int ID> __device__ __forceinline__ int opaque_s(int x) { asm volatile("; opaque scalar %c1" : "+s"(x) : "i"(ID)); return x; }
#define OPAQUE_S(x) opaque_s<__COUNTER__>(x)
__device__ __forceinline__ float fast_sigmoid(float x) { return __builtin_amdgcn_rcpf(1.f + __builtin_amdgcn_exp2f(-LOG2E * x)); }

#define XB_TMO      128
#define XB_XCNT(j)  (256  + 64 * (j))
#define XB_XSUB(j)  (1280 + 64 * (j))
#define XB_XGEN(j)  (2304 + 64 * (j))
#define XB_TOP      3328
#define XB_TOPGEN   3392
#define XCD_BAR_WORDS 3456
#define XB_SPIN_CAP (1u << 18)
template <class P> __device__ __forceinline__ unsigned xb_ld(P p)              { return __hip_atomic_load(p, __ATOMIC_RELAXED, __HIP_MEMORY_SCOPE_AGENT); }
template <class P> __device__ __forceinline__ unsigned xb_add(P p, unsigned v) { return __hip_atomic_fetch_add(p, v, __ATOMIC_RELAXED, __HIP_MEMORY_SCOPE_AGENT); }
__device__ __forceinline__ unsigned xb_xcc_id() { return (unsigned)__builtin_amdgcn_s_getreg((3 << 11) | 20) & 0xFu; }
#define XB_SPIN(cond, bar) do { unsigned _sp = 0; while (cond) { __builtin_amdgcn_s_sleep(1); \
    if ((++_sp & 255u) == 0u) { if (xb_ld(&(bar)[XB_TMO])) break; if (_sp > XB_SPIN_CAP) { (void)xb_add(&(bar)[XB_TMO], 1u); break; } } } } while (0)
struct XcdBarrier { unsigned* bar; unsigned x; volatile LAS unsigned* st; };
__device__ __forceinline__ XcdBarrier xcd_barrier_post(unsigned* bar, volatile LAS unsigned* st) {
    XcdBarrier b; b.bar = bar; b.x = xb_xcc_id(); b.st = st;
    if (threadIdx.x == 0) (void)xb_add((GAS unsigned*)&bar[XB_XCNT(b.x)], 1u);
    return b;
}
__device__ __forceinline__ void xcd_barrier_complete(GAS unsigned* bar, unsigned x, unsigned& nloc, unsigned& nx) {
    const unsigned G = GRID;
    unsigned sum, cnt, mine, sp = 0u;
    for (;;) {
        sum = 0u; cnt = 0u; mine = 0u;
#pragma unroll
        for (unsigned j = 0; j < 16; ++j) { const unsigned c = xb_ld(&bar[XB_XCNT(j)]); sum += c; cnt += (c > 0u) ? 1u : 0u; mine = (j == x) ? c : mine; }
        if (sum == G) break;
        __builtin_amdgcn_s_sleep(1);
        if ((++sp & 255u) == 0u) { if (xb_ld(&bar[XB_TMO])) break; if (sp > XB_SPIN_CAP) { (void)xb_add(&bar[XB_TMO], 1u); break; } }
    }
    nloc = mine > 0u ? mine : 1u; nx = cnt > 0u ? cnt : 1u;
}
template <int ID> __device__ __forceinline__ void xcd_barrier(const XcdBarrier& b, const int tid) {
    asm volatile("s_waitcnt vmcnt(0)" ::: "memory");
    __syncthreads();
    if (tid == 0) {
        unsigned* bar0 = b.bar; asm volatile("; opaque bar %c1" : "+s"(bar0) : "i"(ID)); GAS unsigned* bar = (GAS unsigned*)bar0;
        __builtin_amdgcn_s_waitcnt(0);
        unsigned nloc = b.st[0], nx = b.st[1];
        if (nloc == 0u) { xcd_barrier_complete(bar, b.x, nloc, nx); b.st[0] = nloc; b.st[1] = nx; }
        const unsigned old = xb_add(&bar[XB_XSUB(b.x)], 1u);
        const unsigned gen = old / nloc;
        if (old + 1u == (gen + 1u) * nloc) {
            __builtin_amdgcn_fence(__ATOMIC_RELEASE, "agent");
            asm volatile("s_waitcnt vmcnt(0)" ::: "memory");
            const unsigned og = xb_add(&bar[XB_TOP], 1u);
            const unsigned tg = og / nx;
            if (og + 1u == (tg + 1u) * nx) xb_add(&bar[XB_TOPGEN], 1u);
            else XB_SPIN(xb_ld(&bar[XB_TOPGEN]) == tg, bar);
            __builtin_amdgcn_fence(__ATOMIC_ACQUIRE, "agent");
            xb_add(&bar[XB_XGEN(b.x)], 1u);
            asm volatile("s_waitcnt vmcnt(0)" ::: "memory");
        } else {
            XB_SPIN(xb_ld(&bar[XB_XGEN(b.x)]) == gen, bar);
            __builtin_amdgcn_fence(__ATOMIC_ACQUIRE, "agent");
            asm volatile("s_waitcnt vmcnt(0)" ::: "memory");
        }
    }
    __syncthreads();
}

namespace pg8 {
constexpr int BM = 256, BK = 64, HALF = 128, HTB = HALF * BK * 2, STAGE_BYTES = 8 * HTB, NXCD = 8, WGM = 8;
__host__ __device__ __forceinline__ int lds_byte(int r, int c) { const int st = (r >> 4) * 2 + (c >> 5), rr = r & 15, cc = c & 31, ob = rr * 64 + cc * 2; return st * 1024 + (ob ^ (((ob >> 9) & 1) << 5)); }
__host__ __device__ __forceinline__ void stage_rc(int b, int& R, int& C) { const int st = b / 1024, sb = b % 1024, swz = sb ^ (((sb >> 9) & 1) << 5); R = (st >> 1) * 16 + swz / 64; C = (st & 1) * 32 + (swz % 64) / 2; }
__host__ __device__ __forceinline__ int perm32(int rho) { const int n = rho >> 4, i = rho & 15; return 8 * (i >> 2) + 4 * n + (i & 3); }
struct Unit { int pm, pn; };
struct StaticOrder {
    int nM, nN, nwg, c; static constexpr int G = GRID;
    __device__ __forceinline__ void init(int nM_, int nN_, int, int c_) { nM = nM_; nN = nN_; nwg = nM * nN; c = c_; }
    __device__ __forceinline__ bool next(int i, Unit& u) const {
        const long L = (long)i * G + c; if (L >= nwg) return false;
        int wgid = (int)L; { const int q = nwg / NXCD, r = nwg % NXCD, xcd = wgid % NXCD, off = wgid / NXCD; wgid = (xcd < r ? xcd * (q + 1) : r * (q + 1) + (xcd - r) * q) + off; }
        const int nig = WGM * nN, gid = wgid / nig, fm = gid * WGM, gsz = (nM - fm) < WGM ? (nM - fm) : WGM;
        u.pm = fm + ((wgid % nig) % gsz); u.pn = (wgid % nig) / gsz; return true;
    }
};
struct DenseSched {
    static constexpr bool GATHER = false;
    StaticOrder o; const char* Bt; size_t tstepB;
    __device__ __forceinline__ bool next(int i, Unit& u) const { return o.next(i, u); }
    __device__ __forceinline__ const char* bptr(const Unit& u) const { return Bt + (size_t)u.pn * tstepB; }
};
template <bool GATHER_> struct MoeSched {
    static constexpr bool GATHER = GATHER_;
    StaticOrder o; const char* Bt; size_t tstepB, estepB; int t1, t2, t3, t4, t5, t6, t7;
    __device__ __forceinline__ bool next(int i, Unit& u) const { return o.next(i, u); }
    __device__ __forceinline__ int expert(int pm) const { return (pm >= t1) + (pm >= t2) + (pm >= t3) + (pm >= t4) + (pm >= t5) + (pm >= t6) + (pm >= t7); }
    __device__ __forceinline__ const char* bptr(const Unit& u) const { return Bt + (size_t)expert(u.pm) * estepB + (size_t)u.pn * tstepB; }
};

typedef f32x4 Acc[2][2][4][2];
struct EpiProj {
    static constexpr bool PERM = true;
    bf16_t *AG, *Q, *Kb, *V; const float* bias; float qscale;
    __device__ __forceinline__ void operator()(const Acc& acc, const Unit& u, int wr, int wc, int fr, int fq) const {
        const int pn = u.pn; bf16_t* base; int ldc, colt; float sc = 1.f;
        if (pn < 4) { base = AG; ldc = 1024; colt = pn * 256; }
        else if (pn < 6) { base = Q; ldc = 512; colt = (pn - 4) * 256; sc = qscale; }
        else if (pn < 8) { base = Kb; ldc = 512; colt = (pn - 6) * 256; }
        else { base = V; ldc = 512; colt = (pn - 8) * 256; }
        const int row0 = u.pm * BM + wr * 64 + fr, col0 = colt + wc * 32 + 8 * fq, bcol0 = pn * BM + wc * 32 + 8 * fq;
        f32x4 bv[2][2];
#pragma unroll
        for (int bj = 0; bj < 2; ++bj)
#pragma unroll
            for (int n = 0; n < 2; ++n) bv[bj][n] = *(const f32x4*)(bias + bcol0 + bj * HALF + 4 * n);
#pragma unroll
        for (int ai = 0; ai < 2; ++ai)
#pragma unroll
            for (int m = 0; m < 4; ++m) { bf16_t* rowp = base + (size_t)(row0 + ai * HALF + m * 16) * ldc + col0;
#pragma unroll
                for (int bj = 0; bj < 2; ++bj) { const f32x4 v0 = (acc[ai][bj][m][0] + bv[bj][0]) * sc, v1 = (acc[ai][bj][m][1] + bv[bj][1]) * sc;
                    u32x4 w; w.x = cvt_pk_bf16(v0[0], v0[1]); w.y = cvt_pk_bf16(v0[2], v0[3]); w.z = cvt_pk_bf16(v1[0], v1[1]); w.w = cvt_pk_bf16(v1[2], v1[3]);
                    *(u32x4*)(rowp + bj * HALF) = w; } }
    }
};
struct EpiBf16 {
    static constexpr bool PERM = true;
    bf16_t* O; int ldc;
    __device__ __forceinline__ void operator()(const Acc& acc, const Unit& u, int wr, int wc, int fr, int fq) const {
        const int row0 = u.pm * BM + wr * 64 + fr, col0 = u.pn * BM + wc * 32 + 8 * fq;
#pragma unroll
        for (int ai = 0; ai < 2; ++ai)
#pragma unroll
            for (int m = 0; m < 4; ++m) { bf16_t* rowp = O + (size_t)(row0 + ai * HALF + m * 16) * ldc + col0;
#pragma unroll
                for (int bj = 0; bj < 2; ++bj) { const f32x4 v0 = acc[ai][bj][m][0], v1 = acc[ai][bj][m][1];
                    u32x4 w; w.x = cvt_pk_bf16(v0[0], v0[1]); w.y = cvt_pk_bf16(v0[2], v0[3]); w.z = cvt_pk_bf16(v1[0], v1[1]); w.w = cvt_pk_bf16(v1[2], v1[3]);
                    *(u32x4*)(rowp + bj * HALF) = w; } }
    }
};
struct EpiSwiglu {
    static constexpr bool PERM = true;
    bf16_t* O; int ldc;
    __device__ __forceinline__ void operator()(const Acc& acc, const Unit& u, int wr, int wc, int fr, int fq) const {
        const int row0 = u.pm * BM + wr * 64 + fr, col0 = u.pn * HALF + wc * 32 + 8 * fq;
#pragma unroll
        for (int ai = 0; ai < 2; ++ai)
#pragma unroll
            for (int m = 0; m < 4; ++m) { bf16_t* rowp = O + (size_t)(row0 + ai * HALF + m * 16) * ldc + col0;
                f32x4 r[2];
#pragma unroll
                for (int n = 0; n < 2; ++n) { const f32x4 g = acc[ai][0][m][n], up = acc[ai][1][m][n];
#pragma unroll
                    for (int j = 0; j < 4; ++j) r[n][j] = g[j] * fast_sigmoid(g[j]) * up[j]; }
                u32x4 w; w.x = cvt_pk_bf16(r[0][0], r[0][1]); w.y = cvt_pk_bf16(r[0][2], r[0][3]); w.z = cvt_pk_bf16(r[1][0], r[1][1]); w.w = cvt_pk_bf16(r[1][2], r[1][3]);
                *(u32x4*)rowp = w; }
    }
};
struct EpiResid {
    static constexpr bool PERM = false;
    float* H; const float* bias; float alpha;
    __device__ __forceinline__ void operator()(const Acc& acc, const Unit& u, int wr, int wc, int fr, int fq) const {
        const int row0 = u.pm * BM + wr * 64 + fr, col0 = u.pn * BM + wc * 32 + 4 * fq;
        f32x4 bv[2][2];
#pragma unroll
        for (int bj = 0; bj < 2; ++bj)
#pragma unroll
            for (int n = 0; n < 2; ++n) bv[bj][n] = bias ? *(const f32x4*)(bias + col0 + bj * HALF + n * 16) : (f32x4){0.f, 0.f, 0.f, 0.f};
#pragma unroll
        for (int ai = 0; ai < 2; ++ai)
#pragma unroll
            for (int m = 0; m < 4; ++m) { float* rowp = H + (size_t)(row0 + ai * HALF + m * 16) * D + col0;
#pragma unroll
                for (int bj = 0; bj < 2; ++bj)
#pragma unroll
                    for (int n = 0; n < 2; ++n) { f32x4* p = (f32x4*)(rowp + bj * HALF + n * 16); const f32x4 h = *p; *p = h * alpha + acc[ai][bj][m][n] + bv[bj][n]; }
                if (m & 1) asm volatile("" ::: "memory"); }
    }
};
struct EpiPE {
    static constexpr bool PERM = false;
    bf16_t* O;
    __device__ __forceinline__ void operator()(const Acc& acc, const Unit& u, int wr, int wc, int fr, int fq) const {
        const int row0 = u.pm * BM + wr * 64 + fr, col0 = u.pn * BM + wc * 32 + 4 * fq;
#pragma unroll
        for (int ai = 0; ai < 2; ++ai)
#pragma unroll
            for (int m = 0; m < 4; ++m) { bf16_t* rowp = O + (size_t)(row0 + ai * HALF + m * 16) * D + col0;
#pragma unroll
                for (int bj = 0; bj < 2; ++bj)
#pragma unroll
                    for (int n = 0; n < 2; ++n) { const f32x4 v = acc[ai][bj][m][n]; u32x2 w; w.x = cvt_pk_bf16(v[0], v[1]); w.y = cvt_pk_bf16(v[2], v[3]); *(u32x2*)(rowp + bj * HALF + n * 16) = w; } }
    }
};
struct EpiGate {
    static constexpr bool PERM = false;
    float* H; const bf16_t* PE; const float* bias; float alpha;
    __device__ __forceinline__ void operator()(const Acc& acc, const Unit& u, int wr, int wc, int fr, int fq) const {
        const int row0 = u.pm * BM + wr * 64 + fr, col0 = u.pn * BM + wc * 32 + 4 * fq;
        f32x4 bv[2][2];
#pragma unroll
        for (int bj = 0; bj < 2; ++bj)
#pragma unroll
            for (int n = 0; n < 2; ++n) bv[bj][n] = *(const f32x4*)(bias + col0 + bj * HALF + n * 16);
#pragma unroll
        for (int ai = 0; ai < 2; ++ai)
#pragma unroll
            for (int m = 0; m < 4; ++m) { const size_t off = (size_t)(row0 + ai * HALF + m * 16) * D + col0;
#pragma unroll
                for (int bj = 0; bj < 2; ++bj)
#pragma unroll
                    for (int n = 0; n < 2; ++n) { f32x4* p = (f32x4*)(H + off + bj * HALF + n * 16); const f32x4 h = *p; const u32x2 pe = *(const u32x2*)(PE + off + bj * HALF + n * 16);
                        const f32x4 a = acc[ai][bj][m][n] + bv[bj][n]; f32x4 o;
                        o[0] = h[0] * alpha + fast_sigmoid(a[0]) * bf_lo(pe.x); o[1] = h[1] * alpha + fast_sigmoid(a[1]) * bf_hi(pe.x);
                        o[2] = h[2] * alpha + fast_sigmoid(a[2]) * bf_lo(pe.y); o[3] = h[3] * alpha + fast_sigmoid(a[3]) * bf_hi(pe.y); *p = o; }
                if (m & 1) asm volatile("" ::: "memory"); }
    }
};

template <int SITE, class Epi, class Sched>
__device__ __forceinline__ void gemm_phase(LAS unsigned char* lds, const char* Abase, const int K, const Sched& S, const Epi& E, const LAS unsigned short* tok, const int wid) {
    const int lane = opaque_lane<1000 + 2 * SITE>();
    const int tid = wid * 64 + lane, wr = wid >> 2, wc = wid & 3, fr = lane & 15, fq = lane >> 4;
    const int nt = K / BK;
    unsigned voffB[2], vC[2][2], vN[2][2]; int Rr[2], Cc[2];
#pragma unroll
    for (int i = 0; i < 2; ++i) { int R, C; stage_rc(tid * 16 + i * 8192, R, C); const int Rb = Epi::PERM ? ((R & ~31) + perm32(R & 31)) : R;
        voffB[i] = (unsigned)(Rb * K + C) * 2u; Rr[i] = R; Cc[i] = C;
        vC[0][i] = (unsigned)(R * K + C) * 2u; vC[1][i] = vC[0][i]; vN[0][i] = vC[0][i]; vN[1][i] = vC[0][i]; }
    const size_t kstep = (size_t)(BK * 2);
    const size_t hstep = (size_t)HALF * K * 2;
    const size_t tstep = 2 * hstep;
    const size_t ah = Sched::GATHER ? 0 : hstep;
    const unsigned ldsw = (unsigned)wid * 1024u;
    const int aoff = lds_byte(wr * 64 + fr, fq * 8), boff = lds_byte(wc * 32 + fr, fq * 8);
#define PG8_SA(b, h) (((b) * 2 + (h)) * HTB)
#define PG8_SB(b, h) ((4 + (b) * 2 + (h)) * HTB)
#define PG8_STAGE(bufoff, gbase, voff) do { _Pragma("unroll") for (int _i = 0; _i < 2; ++_i) \
        __builtin_amdgcn_global_load_lds((const unsigned*)((const char*)(gbase) + (voff)[_i]), (LAS unsigned*)(lds + (bufoff) + ldsw + _i * 8192), 16, 0, 0); } while (0)
#define PG8_LDA(dst, b, h) do { _Pragma("unroll") for (int m = 0; m < 4; ++m) _Pragma("unroll") for (int k = 0; k < 2; ++k) dst[m][k] = *(const LAS bf16x8*)(lds + PG8_SA(b, h) + aoff + m * 2048 + k * 1024); } while (0)
#define PG8_LDB(dst, b, h) do { _Pragma("unroll") for (int n = 0; n < 2; ++n) _Pragma("unroll") for (int k = 0; k < 2; ++k) dst[n][k] = *(const LAS bf16x8*)(lds + PG8_SB(b, h) + boff + n * 2048 + k * 1024); } while (0)
#define PG8_MMA(ai, bj, At, Bt) do { __builtin_amdgcn_s_setprio(1); _Pragma("unroll") for (int m = 0; m < 4; ++m) _Pragma("unroll") for (int n = 0; n < 2; ++n) _Pragma("unroll") for (int k = 0; k < 2; ++k) \
        acc[ai][bj][m][n] = __builtin_amdgcn_mfma_f32_16x16x32_bf16(Bt[n][k], At[m][k], acc[ai][bj][m][n], 0, 0, 0); __builtin_amdgcn_s_setprio(0); } while (0)
#define PG8_WAIT_V(n) asm volatile("s_waitcnt vmcnt(" #n ")" ::: "memory")
#define PG8_WAIT_L(n) asm volatile("s_waitcnt lgkmcnt(" #n ")" ::: "memory")
#define PG8_BAR __builtin_amdgcn_s_barrier()
#define PG8_SCHED __builtin_amdgcn_sched_barrier(0)
#define PG8_GATHER(dst, unit_i) do { _Pragma("unroll") for (int _h = 0; _h < 2; ++_h) _Pragma("unroll") for (int _i = 0; _i < 2; ++_i) \
        dst[_h][_i] = (unsigned)tok[(unit_i) * 256 + _h * HALF + Rr[_i]] * (unsigned)(K * 2) + (unsigned)(Cc[_i] * 2); } while (0)
    Unit cur, nxt; int ui = 0;
    if (!S.next(0, cur)) return;
    Acc acc;
#pragma unroll
    for (int a = 0; a < 2; ++a)
#pragma unroll
        for (int b = 0; b < 2; ++b)
#pragma unroll
            for (int m = 0; m < 4; ++m)
#pragma unroll
                for (int n = 0; n < 2; ++n) acc[a][b][m][n] = (f32x4){0.f, 0.f, 0.f, 0.f};
    bf16x8 At[4][2], B0[2][2], B1[2][2];
    if constexpr (Sched::GATHER) { PG8_GATHER(vC, 0); }
    const char* cA = Sched::GATHER ? Abase : Abase + (size_t)cur.pm * tstep; const char* cB = S.bptr(cur);
    PG8_STAGE(PG8_SB(0, 0), cB, voffB); PG8_STAGE(PG8_SB(0, 1), cB + hstep, voffB); PG8_STAGE(PG8_SA(0, 0), cA, vC[0]); PG8_STAGE(PG8_SA(0, 1), cA + ah, vC[1]);
    if (wr == 1) PG8_BAR;
    PG8_WAIT_V(2); PG8_BAR;
    PG8_STAGE(PG8_SB(1, 0), cB + kstep, voffB); PG8_STAGE(PG8_SA(1, 0), cA + kstep, vC[0]); PG8_STAGE(PG8_SB(1, 1), cB + hstep + kstep, voffB);
    PG8_WAIT_V(6); PG8_BAR;
    for (;;) {
        const bool has_next = S.next(ui + 1, nxt);
        const char* nA = (has_next && !Sched::GATHER) ? Abase + (size_t)nxt.pm * tstep : cA; const char* nB = has_next ? S.bptr(nxt) : cB;
        if constexpr (Sched::GATHER) { if (has_next) { PG8_GATHER(vN, ui + 1); } else { vN[0][0] = vC[0][0]; vN[0][1] = vC[0][1]; vN[1][0] = vC[1][0]; vN[1][1] = vC[1][1]; } }
        for (int t = 0; t < nt; t += 2) {
            const bool last = (t == nt - 2);
            const char* a1 = cA + (size_t)(t + 1) * kstep;
            const char* a2 = last ? nA : cA + (size_t)(t + 2) * kstep; const char* b2 = last ? nB : cB + (size_t)(t + 2) * kstep;
            const char* a3 = a2 + kstep; const char* b3 = b2 + kstep;
            unsigned vX[2][2];
            if constexpr (Sched::GATHER) { vX[0][0] = last ? vN[0][0] : vC[0][0]; vX[0][1] = last ? vN[0][1] : vC[0][1]; vX[1][0] = last ? vN[1][0] : vC[1][0]; vX[1][1] = last ? vN[1][1] : vC[1][1]; }
            else { vX[0][0] = vC[0][0]; vX[0][1] = vC[0][1]; vX[1][0] = vC[1][0]; vX[1][1] = vC[1][1]; }
            PG8_LDB(B0, 0, 0); PG8_LDB(B1, 0, 1); PG8_SCHED; PG8_LDA(At, 0, 0); PG8_STAGE(PG8_SA(1, 1), a1 + ah, vC[1]);
            PG8_WAIT_V(8); PG8_WAIT_L(0); PG8_BAR; PG8_MMA(0, 0, At, B0); PG8_MMA(0, 1, At, B1); PG8_BAR; PG8_SCHED;
            PG8_LDA(At, 0, 1); PG8_STAGE(PG8_SB(0, 0), b2, voffB); PG8_STAGE(PG8_SB(0, 1), b2 + hstep, voffB); PG8_STAGE(PG8_SA(0, 0), a2, vX[0]);
            PG8_WAIT_V(8); PG8_WAIT_L(0); PG8_BAR; PG8_MMA(1, 0, At, B0); PG8_MMA(1, 1, At, B1); PG8_BAR; PG8_SCHED;
            PG8_LDB(B0, 1, 0); PG8_LDB(B1, 1, 1); PG8_SCHED; PG8_LDA(At, 1, 0); PG8_STAGE(PG8_SA(0, 1), a2 + ah, vX[1]);
            PG8_WAIT_V(8); PG8_WAIT_L(0); PG8_BAR; PG8_MMA(0, 0, At, B0); PG8_MMA(0, 1, At, B1); PG8_BAR; PG8_SCHED;
            PG8_LDA(At, 1, 1); PG8_STAGE(PG8_SB(1, 0), b3, voffB); PG8_STAGE(PG8_SB(1, 1), b3 + hstep, voffB); PG8_STAGE(PG8_SA(1, 0), a3, vX[0]);
            PG8_WAIT_V(8); PG8_WAIT_L(0); PG8_BAR; PG8_MMA(1, 0, At, B0); PG8_MMA(1, 1, At, B1); PG8_BAR; PG8_SCHED;
        }
        if (wr == 0) PG8_BAR;
        { const int l2 = opaque_lane<1001 + 2 * SITE>(); E(acc, cur, wr, wc, l2 & 15, l2 >> 4); }
        if (!has_next) break;
#pragma unroll
        for (int a = 0; a < 2; ++a)
#pragma unroll
            for (int b = 0; b < 2; ++b)
#pragma unroll
                for (int m = 0; m < 4; ++m)
#pragma unroll
                    for (int n = 0; n < 2; ++n) acc[a][b][m][n] = (f32x4){0.f, 0.f, 0.f, 0.f};
        cur = nxt; cA = nA; cB = nB; ++ui;
        if constexpr (Sched::GATHER) { vC[0][0] = vN[0][0]; vC[0][1] = vN[0][1]; vC[1][0] = vN[1][0]; vC[1][1] = vN[1][1]; }
        if (wr == 1) PG8_BAR;
    }
    PG8_WAIT_V(0);
    PG8_BAR;
#undef PG8_SA
#undef PG8_SB
#undef PG8_STAGE
#undef PG8_LDA
#undef PG8_LDB
#undef PG8_MMA
#undef PG8_WAIT_V
#undef PG8_WAIT_L
#undef PG8_BAR
#undef PG8_SCHED
#undef PG8_GATHER
}
}

struct Args { const float* in[27]; float* out; unsigned char* ws; int ph_lo, ph_hi; };
typedef const __attribute__((address_space(4))) Args* CArgs;
template <int ID> __device__ __forceinline__ CArgs opaque_args() { CArgs p = (CArgs)__builtin_amdgcn_kernarg_segment_ptr(); asm volatile("; opaque args %c1" : "+s"(p) : "i"(ID)); return p; }
#define OPAQUE_ARGS() opaque_args<__COUNTER__>()
struct Frame { LAS unsigned char* lds; int vcu, wave; static constexpr int G = GRID; };
#define AIN(i) ((const float*)(const GAS float*)a->in[i])
#define PHASE_PREAMBLE() CArgs a = OPAQUE_ARGS(); unsigned char* const ws = (unsigned char*)(GAS unsigned char*)a->ws; const int lane = OPAQUE_LANE(), wave = OPAQUE_S(F.wave), vcu = OPAQUE_S(F.vcu), tid = wave * 64 + lane; (void)ws; (void)tid; (void)vcu
constexpr int NPH = 1 + DEPTH * 7;

__device__ __forceinline__ void tr_item(const float* W, int N, bf16_t* WT, int ldt, int k0, int n0, int orow0, LAS float* scr, int lane) {
#pragma unroll 8
    for (int i = 0; i < 32; ++i) { const int kk = 2 * i + (lane >> 5); scr[kk * 33 + (lane & 31)] = W[(size_t)(k0 + kk) * N + n0 + (lane & 31)]; }
    LDS_WAIT(); asm volatile("" ::: "memory");
    const int c = lane & 7;
#pragma unroll
    for (int j = 0; j < 4; ++j) { const int n = (lane >> 3) + 8 * j; const LAS float* s = scr + (8 * c) * 33 + n;
        u32x4 o; o.x = cvt_pk_bf16(s[0 * 33], s[1 * 33]); o.y = cvt_pk_bf16(s[2 * 33], s[3 * 33]); o.z = cvt_pk_bf16(s[4 * 33], s[5 * 33]); o.w = cvt_pk_bf16(s[6 * 33], s[7 * 33]);
        *(u32x4*)(WT + (size_t)(orow0 + n) * ldt + k0 + 8 * c) = o; }
    LDS_WAIT(); asm volatile("" ::: "memory");
}
__device__ __forceinline__ void cvt_class_item(const float* W0, int K, int N, bf16_t* WT0, size_t wt_stride  , int il, int r, LAS float* scr, int lane) {
    const int nblk = N / 32, per = (K / 64) * nblk, mat = r / per, it = r % per, kb = it / nblk, nb = it % nblk, n0 = 32 * nb;
    const int orow0 = il == 0 ? n0 : ((n0 >> 7) * 256 + (n0 & 127) + (il == 2 ? 128 : 0));
    tr_item(W0 + (size_t)mat * K * N, N, WT0 + (size_t)mat * wt_stride, K, 64 * kb, n0, orow0, scr, lane);
}
__device__ __forceinline__ void cvt_static_weights(const Frame& F, CArgs a, unsigned char* ws, int lane, int wave, int vcu) {
    LAS float* scr = (LAS float*)(F.lds + wave * 16384);
    const int gw = vcu * NWAVES + wave, NGW = F.G * NWAVES;
    constexpr int I_IN = 4 * (D / 64) * (DIN / 32), I_OUT = 4 * (D / 64) * (D / 32), I_G = I_OUT, I_P = 4 * (DPLE / 64) * (D / 32), I_F1 = 2 * (D / 64) * (DFF / 32), I_F2 = 2 * (DFF / 64) * (D / 32);
    constexpr int NIT = I_IN + I_OUT + I_G + I_P + 2 * I_F1 + I_F2;
    for (int it = gw; it < NIT; it += NGW) {
        int r = it;
        if (r < I_IN) { cvt_class_item(AIN(4), D, DIN, (bf16_t*)(ws + WS_WIN), (size_t)DIN * D, 0, r, scr, lane); continue; } r -= I_IN;
        if (r < I_OUT) { cvt_class_item(AIN(11), D, D, (bf16_t*)(ws + WS_WOUT), (size_t)D * D, 0, r, scr, lane); continue; } r -= I_OUT;
        if (r < I_G) { cvt_class_item(AIN(23), D, D, (bf16_t*)(ws + WS_WG), (size_t)D * D, 0, r, scr, lane); continue; } r -= I_G;
        if (r < I_P) { cvt_class_item(AIN(22), DPLE, D, (bf16_t*)(ws + WS_WP), (size_t)D * DPLE, 0, r, scr, lane); continue; } r -= I_P;
        if (r < I_F1) { cvt_class_item(AIN(15), D, DFF, (bf16_t*)(ws + WS_W13), (size_t)2 * DFF * D, 1, r, scr, lane); continue; } r -= I_F1;
        if (r < I_F1) { cvt_class_item(AIN(16), D, DFF, (bf16_t*)(ws + WS_W13), (size_t)2 * DFF * D, 2, r, scr, lane); continue; } r -= I_F1;
        cvt_class_item(AIN(17), DFF, D, (bf16_t*)(ws + WS_W2), (size_t)D * DFF, 0, r, scr, lane);
    }
}
__device__ __forceinline__ void cvt_moe_weights(const Frame& F, CArgs a, unsigned char* ws, int lane, int wave, int vcu, int j) {
    LAS float* scr = (LAS float*)(F.lds + wave * 16384);
    const int gw = vcu * NWAVES + wave, NGW = F.G * NWAVES;
    constexpr int I_1 = NE * (D / 64) * (DFE / 32), I_2 = NE * (DFE / 64) * (D / 32);
    const size_t wo = (size_t)j * NE * D * DFE;
    for (int it = gw; it < 2 * I_1 + I_2; it += NGW) {
        int r = it;
        if (r < I_1) { cvt_class_item(AIN(19) + wo, D, DFE, (bf16_t*)(ws + WS_WM), WM13_E / 2, 1, r, scr, lane); continue; } r -= I_1;
        if (r < I_1) { cvt_class_item(AIN(20) + wo, D, DFE, (bf16_t*)(ws + WS_WM), WM13_E / 2, 2, r, scr, lane); continue; } r -= I_1;
        cvt_class_item(AIN(21) + wo, DFE, D, (bf16_t*)(ws + WS_WM2), WM2_E / 2, 0, r, scr, lane);
    }
}

__device__ __forceinline__ void ln_row(f32x4 (&v)[4], const f32x4 (&g)[4], const f32x4 (&b)[4]) {
    float s = 0.f;
#pragma unroll
    for (int j = 0; j < 4; ++j) s += (v[j][0] + v[j][1]) + (v[j][2] + v[j][3]);
    const float mean = wave_sum(s) * (1.f / D); float q = 0.f;
#pragma unroll
    for (int j = 0; j < 4; ++j) { v[j] = v[j] - mean; q += (v[j][0] * v[j][0] + v[j][1] * v[j][1]) + (v[j][2] * v[j][2] + v[j][3] * v[j][3]); }
    const float rstd = 1.f / sqrtf(wave_sum(q) * (1.f / D) + LN_EPS);
#pragma unroll
    for (int j = 0; j < 4; ++j) v[j] = v[j] * rstd * g[j] + b[j];
}
__device__ __forceinline__ void store_row(const f32x4 (&v)[4], float* h32row, bf16_t* hbrow, int lane) {
#pragma unroll
    for (int j = 0; j < 4; ++j) {
        if (h32row) *(f32x4*)(h32row + 4 * lane + 256 * j) = v[j];
        if (hbrow) { u32x2 w; w.x = cvt_pk_bf16(v[j][0], v[j][1]); w.y = cvt_pk_bf16(v[j][2], v[j][3]); *(u32x2*)(hbrow + 4 * lane + 256 * j) = w; }
    }
}

__device__ __forceinline__ void ph_prologue(const Frame& F) {
    PHASE_PREAMBLE();
    cvt_static_weights(F, a, ws, lane, wave, vcu);
    cvt_moe_weights(F, a, ws, lane, wave, vcu, 0);
    const int gw = vcu * NWAVES + wave, NGW = F.G * NWAVES;
    f32x4 g[4], b[4];
#pragma unroll
    for (int j = 0; j < 4; ++j) { g[j] = *(const f32x4*)(AIN(2) + 4 * lane + 256 * j); b[j] = *(const f32x4*)(AIN(3) + 4 * lane + 256 * j); }
    float* H32 = (float*)(ws + WS_H32); bf16_t* HB = (bf16_t*)(ws + WS_HB);
    for (int m = gw; m < M; m += NGW) {
        f32x4 v[4];
#pragma unroll
        for (int j = 0; j < 4; ++j) v[j] = *(const f32x4*)(AIN(0) + (size_t)m * D + 4 * lane + 256 * j);
        ln_row(v, g, b);
        store_row(v, H32 + (size_t)m * D, HB + (size_t)m * D, lane);
    }
}

__device__ __forceinline__ void ph_conv(const Frame& F, int layer) {
    PHASE_PREAMBLE();
    const bf16_t* AG = (const bf16_t*)(ws + WS_AG); bf16_t* MIX = (bf16_t*)(ws + WS_MIX);
    LAS float* U = (LAS float*)F.lds;
    const int c = tid;
    const float* cw = AIN(6) + (size_t)layer * CONV_K * CONV_CH; const float cb = AIN(7)[layer * CONV_CH + c];
    float w[CONV_K];
#pragma unroll
    for (int k = 0; k < CONV_K; ++k) w[k] = cw[k * CONV_CH + c];
    const float* lg = AIN(8) + layer * CONV_CH; const float* lb = AIN(9) + layer * CONV_CH;
    for (int unit = vcu; unit < M / 32; unit += F.G) {
        const int t0 = unit * 32, bt = t0 / SEQ, tt0 = t0 % SEQ;
        for (int r = 0; r < 62; ++r) {
            const int ts = tt0 + r - 15; float u = 0.f;
            if (ts >= 0 && ts < SEQ) { const bf16_t* p = AG + ((size_t)bt * SEQ + ts) * 1024; const float av = bf2f(p[c]), gv = bf2f(p[CONV_CH + c]); u = av * fast_sigmoid(gv); }
            U[r * CONV_CH + c] = u;
        }
        __syncthreads();
        float y[32];
#pragma unroll
        for (int t = 0; t < 32; ++t) y[t] = cb;
#pragma unroll
        for (int r = 0; r < 62; ++r) { const float x = U[r * CONV_CH + c];
#pragma unroll
            for (int t = 0; t < 32; ++t) if (r - t >= 0 && r - t < CONV_K) y[t] += w[r - t] * x; }
        __syncthreads();
#pragma unroll
        for (int t = 0; t < 32; ++t) U[t * CONV_CH + c] = y[t];
        __syncthreads();
#pragma unroll
        for (int i = 0; i < 4; ++i) { const int t = wave * 4 + i; float v[8]; float s = 0.f;
#pragma unroll
            for (int j = 0; j < 8; ++j) { v[j] = U[t * CONV_CH + lane + 64 * j]; s += v[j]; }
            const float mean = wave_sum(s) * (1.f / CONV_CH); float q = 0.f;
#pragma unroll
            for (int j = 0; j < 8; ++j) { v[j] -= mean; q += v[j] * v[j]; }
            const float rstd = 1.f / sqrtf(wave_sum(q) * (1.f / CONV_CH) + LN_EPS);
#pragma unroll
            for (int j = 0; j < 8; ++j) { float o = v[j] * rstd * lg[lane + 64 * j] + lb[lane + 64 * j]; o = o * fast_sigmoid(o);
                MIX[(size_t)(t0 + t) * 1024 + lane + 64 * j] = (bf16_t)(cvt_pk_bf16(o, 0.f) & 0xffffu); } }
        __syncthreads();
    }
}
__device__ __forceinline__ void ph_attn_simple(const Frame& F, int layer) {
    PHASE_PREAMBLE();
    const bf16_t* Q = (const bf16_t*)(ws + WS_Q); const bf16_t* Kb = (const bf16_t*)(ws + WS_K); const bf16_t* V = (const bf16_t*)(ws + WS_V); bf16_t* MIX = (bf16_t*)(ws + WS_MIX);
    const float* rpb = AIN(10) + (size_t)layer * NH * 15 * 31;
    const int gw = vcu * NWAVES + wave, NGW = F.G * NWAVES;
    for (int w = gw; w < M * NH; w += NGW) {
        const int t = w / NH, h = w % NH;
        const int bt = t / SEQ, tt = t % SEQ, r = tt / GRID_W, c = tt % GRID_W;
        int r0 = r - 4; r0 = r0 < 0 ? 0 : (r0 > ROWS - 8 ? ROWS - 8 : r0);
        int c0 = c - 8; c0 = c0 < 0 ? 0 : (c0 > GRID_W - 16 ? GRID_W - 16 : c0);
        const float q = bf2f(Q[(size_t)t * 512 + h * HD + lane]);
        float mx = -INFINITY, l = 0.f, acc = 0.f;
        for (int i = 0; i < 8; ++i)
            for (int j = 0; j < 16; ++j) {
                const int kr = r0 + i, kc = c0 + j; const size_t kt = (size_t)bt * SEQ + kr * GRID_W + kc;
                const float kv = bf2f(Kb[kt * 512 + h * HD + lane]), vv = bf2f(V[kt * 512 + h * HD + lane]);
                const float s = wave_sum(q * kv) + LOG2E * rpb[(h * 15 + (kr - r + 7)) * 31 + (kc - c + 15)];
                const float nm = fmaxf(mx, s), f = __builtin_amdgcn_exp2f(mx - nm), p = __builtin_amdgcn_exp2f(s - nm);
                l = l * f + p; acc = acc * f + p * vv; mx = nm;
            }
        MIX[(size_t)t * 1024 + CONV_CH + h * HD + lane] = (bf16_t)(cvt_pk_bf16(acc / l, 0.f) & 0xffffu);
    }
}

__device__ __forceinline__ void ph_ln1(const Frame& F, int layer) {
    PHASE_PREAMBLE();
    const bool moe = (layer & 1) != 0; const int jm = layer >> 1;
    float* H32 = (float*)(ws + WS_H32); bf16_t* HB = (bf16_t*)(ws + WS_HB);
    LAS float* WR = (LAS float*)F.lds;
    LAS unsigned* lcnt = (LAS unsigned*)(F.lds + 32768);
    if (moe) {
        const float* wr = AIN(18) + (size_t)jm * D * NE;
        for (int i = tid; i < D * NE / 4; i += NWAVES * 64) ((LAS f32x4*)WR)[i] = ((const f32x4*)wr)[i];
        if (tid < 16) lcnt[tid] = 0u;
        __syncthreads();
    }
    f32x4 g[4], b[4];
#pragma unroll
    for (int j = 0; j < 4; ++j) { g[j] = *(const f32x4*)(AIN(13) + layer * D + 4 * lane + 256 * j); b[j] = *(const f32x4*)(AIN(14) + layer * D + 4 * lane + 256 * j); }
    const int gw = vcu * NWAVES + wave;
    int me0 = 0, me1 = 0; float mg0 = 0.f, mg1 = 0.f;
    for (int i = 0; i < 16; ++i) {
        const int m = gw * 16 + i;
        f32x4 v[4];
#pragma unroll
        for (int j = 0; j < 4; ++j) v[j] = *(const f32x4*)(H32 + (size_t)m * D + 4 * lane + 256 * j);
        ln_row(v, g, b);
        store_row(v, H32 + (size_t)m * D, HB + (size_t)m * D, lane);
        if (moe) {
            float lgt[NE];
#pragma unroll
            for (int e = 0; e < NE; ++e) lgt[e] = 0.f;
#pragma unroll
            for (int j = 0; j < 4; ++j)
#pragma unroll
                for (int k = 0; k < 4; ++k) { const int d = 4 * lane + 256 * j + k; const f32x4 w0 = *(const LAS f32x4*)(WR + d * 8), w1 = *(const LAS f32x4*)(WR + d * 8 + 4); const float x = v[j][k];
                    lgt[0] += x * w0[0]; lgt[1] += x * w0[1]; lgt[2] += x * w0[2]; lgt[3] += x * w0[3]; lgt[4] += x * w1[0]; lgt[5] += x * w1[1]; lgt[6] += x * w1[2]; lgt[7] += x * w1[3]; }
#pragma unroll
            for (int e = 0; e < NE; ++e) lgt[e] = wave_sum(lgt[e]);
            int i0 = 0; float v0 = lgt[0];
#pragma unroll
            for (int e = 1; e < NE; ++e) if (lgt[e] > v0) { v0 = lgt[e]; i0 = e; }
            int i1 = -1; float v1 = -INFINITY;
#pragma unroll
            for (int e = 0; e < NE; ++e) if (e != i0 && lgt[e] > v1) { v1 = lgt[e]; i1 = e; }
            const float g1 = 1.f / (1.f + __expf(v0 - v1)), g0 = 1.f - g1;
            if (lane == i) { me0 = i0; me1 = i1; mg0 = g0; mg1 = g1; }
        }
    }
    if (moe) {
        gu32* cnt = ((gu32*)(ws + WS_CTL)) + CW_CNT + jm * 8 * 64;
        const int oe1 = __builtin_amdgcn_ds_bpermute((lane & 15) << 2, me1);
        const bool valid = lane < 32; const int k = lane >> 4; const int mye = valid ? (k ? oe1 : me0) : -1;
        unsigned slot = 0;
#pragma unroll
        for (int e = 0; e < NE; ++e) { const unsigned long long mask = __ballot(mye == e); const unsigned c = (unsigned)__popcll(mask);
            unsigned wb = 0; if (lane == 0 && c) wb = __hip_atomic_fetch_add(lcnt + e, c, __ATOMIC_RELAXED, __HIP_MEMORY_SCOPE_WORKGROUP);
            wb = (unsigned)__builtin_amdgcn_readfirstlane((int)wb);
            if (mye == e) slot = wb + (unsigned)__popcll(mask & ((1ull << lane) - 1ull)); }
        __syncthreads();
        if (tid < NE) lcnt[8 + tid] = __hip_atomic_fetch_add(cnt + 64 * tid, lcnt[tid], RLX_AGENT);
        __syncthreads();
        if (valid) {
            slot += lcnt[8 + mye];
            const int row = gw * 16 + (lane & 15);
            ((unsigned*)(ws + WS_LIST))[(size_t)mye * M + slot] = (unsigned)row;
            ((unsigned*)(ws + WS_TOKS))[2 * row + k] = slot;
            if (k == 0) { ((unsigned*)(ws + WS_TOKE))[row] = (unsigned)me0 | ((unsigned)me1 << 8); ((float*)(ws + WS_TOKG))[2 * row] = mg0; ((float*)(ws + WS_TOKG))[2 * row + 1] = mg1; }
        }
    }
    const float* P = AIN(1) + (size_t)layer * M * DPLE + (size_t)gw * 16 * DPLE; bf16_t* PB = (bf16_t*)(ws + WS_PBL) + (size_t)gw * 16 * DPLE;
#pragma unroll 4
    for (int i = 0; i < 16; ++i) { const f32x4 x = *(const f32x4*)(P + i * 256 + 4 * lane); u32x2 w; w.x = cvt_pk_bf16(x[0], x[1]); w.y = cvt_pk_bf16(x[2], x[3]); *(u32x2*)(PB + i * 256 + 4 * lane) = w; }
}

struct MoeTiles { int cnt[NE]; int ts[NE + 1]; };
__device__ __forceinline__ void moe_tiles(unsigned char* ws, int jm, MoeTiles& T) {
    gu32* cnt = ((gu32*)(ws + WS_CTL)) + CW_CNT + jm * 8 * 64; int s = 0;
#pragma unroll
    for (int e = 0; e < NE; ++e) { const int c = __builtin_amdgcn_readfirstlane((int)__hip_atomic_load(cnt + 64 * e, RLX_AGENT)); T.cnt[e] = c; T.ts[e] = s; s += (c + 255) >> 8; }
    T.ts[NE] = s;
}

__device__ __forceinline__ void ph_ln2(const Frame& F, int layer) {
    PHASE_PREAMBLE();
    const bool moe = (layer & 1) != 0; const int jm = layer >> 1;
    float* H32 = (float*)(ws + WS_H32); bf16_t* HB = (bf16_t*)(ws + WS_HB); const bf16_t* Y = (const bf16_t*)(ws + WS_Y);
    MoeTiles T; if (moe) moe_tiles(ws, jm, T);
    f32x4 g[4], b[4];
#pragma unroll
    for (int j = 0; j < 4; ++j) { g[j] = *(const f32x4*)(AIN(25) + layer * D + 4 * lane + 256 * j); b[j] = *(const f32x4*)(AIN(26) + layer * D + 4 * lane + 256 * j); }
    const int gw = vcu * NWAVES + wave, NGW = F.G * NWAVES;
    for (int m = gw; m < M; m += NGW) {
        f32x4 v[4];
#pragma unroll
        for (int j = 0; j < 4; ++j) v[j] = *(const f32x4*)(H32 + (size_t)m * D + 4 * lane + 256 * j);
        if (moe) {
            const unsigned ee = ((const unsigned*)(ws + WS_TOKE))[m]; const int e0 = ee & 0xff, e1 = (ee >> 8) & 0xff;
            const unsigned s0 = ((const unsigned*)(ws + WS_TOKS))[2 * m], s1 = ((const unsigned*)(ws + WS_TOKS))[2 * m + 1];
            const float g0 = ((const float*)(ws + WS_TOKG))[2 * m], g1 = ((const float*)(ws + WS_TOKG))[2 * m + 1];
            int t0 = 0, t1 = 0;
#pragma unroll
            for (int e = 0; e < NE; ++e) { if (e == e0) t0 = T.ts[e]; if (e == e1) t1 = T.ts[e]; }
            const bf16_t* y0 = Y + ((size_t)t0 * 256 + s0) * D; const bf16_t* y1 = Y + ((size_t)t1 * 256 + s1) * D;
#pragma unroll
            for (int j = 0; j < 4; ++j) { const u32x2 p0 = *(const u32x2*)(y0 + 4 * lane + 256 * j), p1 = *(const u32x2*)(y1 + 4 * lane + 256 * j);
                v[j][0] += g0 * bf_lo(p0.x) + g1 * bf_lo(p1.x); v[j][1] += g0 * bf_hi(p0.x) + g1 * bf_hi(p1.x);
                v[j][2] += g0 * bf_lo(p0.y) + g1 * bf_lo(p1.y); v[j][3] += g0 * bf_hi(p0.y) + g1 * bf_hi(p1.y); }
        }
        ln_row(v, g, b);
        if (layer == DEPTH - 1) store_row(v, ((float*)(GAS float*)a->out) + (size_t)m * D, nullptr, lane);
        else store_row(v, H32 + (size_t)m * D, HB + (size_t)m * D, lane);
    }
}

__global__ void __launch_bounds__(NWAVES * 64, 2) mk_fwd(Args args) {
    extern __shared__ __attribute__((aligned(16))) unsigned char lds[];
    Frame F;
    F.lds = (LAS unsigned char*)lds;
    volatile LAS unsigned* MISC = (volatile LAS unsigned*)(F.lds + MISC_OFF);
    F.wave = __builtin_amdgcn_readfirstlane((int)(threadIdx.x >> 6));
    { const int bx = blockIdx.x; F.vcu = (bx % 8) * (GRID / 8) + bx / 8; }
    if (threadIdx.x < 64) MISC[threadIdx.x] = 0u;
    __syncthreads();
    const int lo = args.ph_lo, hi = args.ph_hi;
    XcdBarrier bar; bar.bar = (unsigned*)(args.ws + WS_CTL) + CW_BAR; bar.x = 0; bar.st = nullptr;
    if (hi - lo > 1) bar = xcd_barrier_post((unsigned*)(args.ws + WS_CTL) + CW_BAR, MISC + 8);
#define IN(k) (lo <= (k) && (k) < hi)
#define SEAM(k) do { if (IN(k) && IN((k) + 1)) xcd_barrier<__COUNTER__>(bar, F.wave * 64 + OPAQUE_LANE()); } while (0)
    const LAS unsigned short* tok = (const LAS unsigned short*)(F.lds + TOK_OFF);
    const int c = (int)blockIdx.x;

    if (IN(0)) { ph_prologue(F); } SEAM(0);

    for (int layer = 0; layer < DEPTH; ++layer) {
        const int pb = 1 + layer * 7; const int jd = layer >> 1;
        if (IN(pb + 0)) {
            CArgs a = OPAQUE_ARGS(); unsigned char* const ws = (unsigned char*)(GAS unsigned char*)a->ws;
            pg8::DenseSched S; S.o.init(M / 256, DIN / 256, F.G, OPAQUE_S(c)); S.Bt = (const char*)(ws + WS_WIN) + (size_t)layer * DIN * D * 2; S.tstepB = (size_t)256 * D * 2;
            pg8::EpiProj E{(bf16_t*)(ws + WS_AG), (bf16_t*)(ws + WS_Q), (bf16_t*)(ws + WS_K), (bf16_t*)(ws + WS_V), AIN(5) + layer * DIN, QSCALE};
            pg8::gemm_phase<1>(F.lds, (const char*)(ws + WS_HB), D, S, E, tok, OPAQUE_S(F.wave));
        } SEAM(pb + 0);
        if (IN(pb + 1)) { ph_conv(F, layer); ph_attn_simple(F, layer); } SEAM(pb + 1);
        if (IN(pb + 2)) {
            CArgs a = OPAQUE_ARGS(); unsigned char* const ws = (unsigned char*)(GAS unsigned char*)a->ws;
            pg8::DenseSched S; S.o.init(M / 256, D / 256, F.G, OPAQUE_S(c)); S.Bt = (const char*)(ws + WS_WOUT) + (size_t)layer * D * D * 2; S.tstepB = (size_t)256 * D * 2;
            pg8::EpiResid E{(float*)(ws + WS_H32), AIN(12) + layer * D, ALPHA};
            pg8::gemm_phase<2>(F.lds, (const char*)(ws + WS_MIX), D, S, E, tok, OPAQUE_S(F.wave));
        } SEAM(pb + 2);
        if (IN(pb + 3)) { ph_ln1(F, layer); if (layer == 2) { __syncthreads(); PHASE_PREAMBLE(); cvt_moe_weights(F, a, ws, lane, wave, vcu, 1); } } SEAM(pb + 3);
        if (IN(pb + 4)) {
            {   CArgs a = OPAQUE_ARGS(); unsigned char* const ws = (unsigned char*)(GAS unsigned char*)a->ws;
                pg8::DenseSched S; S.o.init(M / 256, D / 256, F.G, OPAQUE_S(c)); S.Bt = (const char*)(ws + WS_WP) + (size_t)layer * D * DPLE * 2; S.tstepB = (size_t)256 * DPLE * 2;
                pg8::EpiPE E{(bf16_t*)(ws + WS_PE)};
                pg8::gemm_phase<3>(F.lds, (const char*)(ws + WS_PBL), DPLE, S, E, tok, OPAQUE_S(F.wave)); }
            {   CArgs a = OPAQUE_ARGS(); unsigned char* const ws = (unsigned char*)(GAS unsigned char*)a->ws;
                pg8::DenseSched S; S.o.init(M / 256, D / 256, F.G, OPAQUE_S(c)); S.Bt = (const char*)(ws + WS_WG) + (size_t)layer * D * D * 2; S.tstepB = (size_t)256 * D * 2;
                pg8::EpiGate E{(float*)(ws + WS_H32), (const bf16_t*)(ws + WS_PE), AIN(24) + layer * D, ALPHA};
                pg8::gemm_phase<4>(F.lds, (const char*)(ws + WS_HB), D, S, E, tok, OPAQUE_S(F.wave)); }
            if ((layer & 1) == 0) {
                CArgs a = OPAQUE_ARGS(); unsigned char* const ws = (unsigned char*)(GAS unsigned char*)a->ws;
                pg8::DenseSched S; S.o.init(M / 256, 2 * DFF / 256, F.G, OPAQUE_S(c)); S.Bt = (const char*)(ws + WS_W13) + (size_t)jd * 2 * DFF * D * 2; S.tstepB = (size_t)256 * D * 2;
                pg8::EpiSwiglu E{(bf16_t*)(ws + WS_ACT), DFF};
                pg8::gemm_phase<5>(F.lds, (const char*)(ws + WS_HB), D, S, E, tok, OPAQUE_S(F.wave));
            } else {
                PHASE_PREAMBLE();
                MoeTiles T; moe_tiles(ws, jd, T);
                pg8::MoeSched<true> S; S.o.init(T.ts[NE], 2 * DFE / 256, F.G, OPAQUE_S(c)); S.Bt = (const char*)(ws + WS_WM); S.tstepB = (size_t)256 * D * 2; S.estepB = WM13_E;
                S.t1 = T.ts[1]; S.t2 = T.ts[2]; S.t3 = T.ts[3]; S.t4 = T.ts[4]; S.t5 = T.ts[5]; S.t6 = T.ts[6]; S.t7 = T.ts[7];
                {   LAS unsigned short* tw = (LAS unsigned short*)(F.lds + TOK_OFF); const unsigned* list = (const unsigned*)(ws + WS_LIST); pg8::Unit u;
                    for (int i = 0; i < 32 && S.next(i, u); ++i) { const int e = S.expert(u.pm);
                        int ce = 0, te = 0;
#pragma unroll
                        for (int x = 0; x < NE; ++x) if (x == e) { ce = T.cnt[x]; te = T.ts[x]; }
                        if (tid < 256) { const int s = (u.pm - te) * 256 + tid; tw[i * 256 + tid] = (unsigned short)(s < ce ? list[(size_t)e * M + s] : 0u); } }
                    __syncthreads(); }
                pg8::EpiSwiglu E{(bf16_t*)(ws + WS_ACT), DFE};
                pg8::gemm_phase<6>(F.lds, (const char*)(ws + WS_HB), D, S, E, tok, OPAQUE_S(F.wave));
            }
        } SEAM(pb + 4);
        if (IN(pb + 5)) {
            if ((layer & 1) == 0) {
                CArgs a = OPAQUE_ARGS(); unsigned char* const ws = (unsigned char*)(GAS unsigned char*)a->ws;
                pg8::DenseSched S; S.o.init(M / 256, D / 256, F.G, OPAQUE_S(c)); S.Bt = (const char*)(ws + WS_W2) + (size_t)jd * D * DFF * 2; S.tstepB = (size_t)256 * DFF * 2;
                pg8::EpiResid E{(float*)(ws + WS_H32), nullptr, 1.f};
                pg8::gemm_phase<7>(F.lds, (const char*)(ws + WS_ACT), DFF, S, E, tok, OPAQUE_S(F.wave));
            } else {
                CArgs a = OPAQUE_ARGS(); unsigned char* const ws = (unsigned char*)(GAS unsigned char*)a->ws;
                MoeTiles T; moe_tiles(ws, jd, T);
                pg8::MoeSched<false> S; S.o.init(T.ts[NE], D / 256, F.G, OPAQUE_S(c)); S.Bt = (const char*)(ws + WS_WM2); S.tstepB = (size_t)256 * DFE * 2; S.estepB = WM2_E;
                S.t1 = T.ts[1]; S.t2 = T.ts[2]; S.t3 = T.ts[3]; S.t4 = T.ts[4]; S.t5 = T.ts[5]; S.t6 = T.ts[6]; S.t7 = T.ts[7];
                pg8::EpiBf16 E{(bf16_t*)(ws + WS_Y), D};
                pg8::gemm_phase<8>(F.lds, (const char*)(ws + WS_ACT), DFE, S, E, tok, OPAQUE_S(F.wave));
            }
        } SEAM(pb + 5);
        if (IN(pb + 6)) { ph_ln2(F, layer); } SEAM(pb + 6);
    }
#undef IN
#undef SEAM
}

extern "C" void kernel_launch(void* const* d_in, const int* in_sizes, int n_in, void* d_out, int out_size, void* d_ws, size_t ws_size, hipStream_t stream) {
    static int grid = 0;
    if (grid == 0) {
        if (n_in != 27 || out_size != M * D || ws_size < WS_END) { fprintf(stderr, "kernel_launch: unexpected problem (n_in %d, out %d, ws %zu < %zu)\n", n_in, out_size, ws_size, (size_t)WS_END); grid = -1; return; }
        int dev = 0, cus = 0, per_cu = 0;
        if (hipGetDevice(&dev) != hipSuccess || hipDeviceGetAttribute(&cus, hipDeviceAttributeMultiprocessorCount, dev) != hipSuccess) { grid = -1; return; }
        if (hipFuncSetAttribute((const void*)mk_fwd, hipFuncAttributeMaxDynamicSharedMemorySize, LDS_BYTES) != hipSuccess) { fprintf(stderr, "kernel_launch: hipFuncSetAttribute failed\n"); grid = -1; return; }
        if (hipOccupancyMaxActiveBlocksPerMultiprocessor(&per_cu, (const void*)mk_fwd, NWAVES * 64, LDS_BYTES) != hipSuccess || per_cu < 1) fprintf(stderr, "kernel_launch: occupancy query says %d\n", per_cu);
        (void)hipGetLastError();
        if (cus < GRID) { fprintf(stderr, "kernel_launch: %d CUs; built for %d\n", cus, GRID); grid = -1; return; }
        grid = GRID;
    }
    if (grid < 0) return;
    if (hipMemsetAsync((char*)d_ws + WS_CTL, 0, CTL_ZERO_BYTES, stream) != hipSuccess) return;
    Args a{};
    for (int i = 0; i < 27; ++i) a.in[i] = (const float*)d_in[i];
    a.out = (float*)d_out; a.ws = (unsigned char*)d_ws;
#if MK_MULTI
    for (int ph = 0; ph < NPH; ++ph) { a.ph_lo = ph; a.ph_hi = ph + 1; hipLaunchKernelGGL(mk_fwd, dim3(grid), dim3(NWAVES * 64), LDS_BYTES, stream, a); }
#else
    a.ph_lo = 0; a.ph_hi = NPH; hipLaunchKernelGGL(mk_fwd, dim3(grid), dim3(NWAVES * 64), LDS_BYTES, stream, a);
#endif
}
```

```cpp
#include <hip/hip_runtime.h>
#include <cstdio>
#include <cstdint>

#ifndef MK_MULTI
#define MK_MULTI 0
#endif

#define GAS __attribute__((address_space(1)))
#define LAS __attribute__((address_space(3)))
typedef unsigned short bf16_t;
typedef short bf16x8 __attribute__((ext_vector_type(8)));
typedef float f32x4 __attribute__((ext_vector_type(4)));
typedef float f32x2 __attribute__((ext_vector_type(2)));
typedef unsigned u32x4 __attribute__((ext_vector_type(4)));
typedef unsigned u32x2 __attribute__((ext_vector_type(2)));
typedef GAS unsigned gu32;

constexpr int D = 1024, BATCH = 4, SEQ = 8192, DEPTH = 4, M = BATCH * SEQ;
constexpr int CONV_CH = 512, NH = 8, HD = 64, DIN = 2560, CONV_K = 31, GRID_W = 64, ROWS = SEQ / GRID_W;
constexpr int DFF = 2816, NE = 8, DFE = 3584, DPLE = 256;
constexpr float LN_EPS = 1e-5f;
constexpr float ALPHA = 1.681792830507429f;
constexpr float LOG2E = 1.4426950408889634f;
constexpr float QSCALE = 0.125f * LOG2E;
constexpr int NWAVES = 8;
constexpr int GRID = 256;
constexpr int MAXT = 263;

constexpr size_t MiB = 1u << 20;
constexpr size_t WS_CTL = 0, CTL_ZERO_BYTES = 1 * MiB;
constexpr size_t WS_TOKE = 1 * MiB;
constexpr size_t WS_TOKS = WS_TOKE + 128 * 1024;
constexpr size_t WS_TOKG = WS_TOKS + 256 * 1024;
constexpr size_t WS_LIST = 2 * MiB;
constexpr size_t WS_H32 = 4 * MiB;
constexpr size_t WS_HB = 132 * MiB;
constexpr size_t WS_PE = 196 * MiB;
constexpr size_t WS_Y = WS_PE;
constexpr size_t WS_PBL = 328 * MiB;
constexpr size_t WS_ACT = 344 * MiB;
constexpr size_t WS_AG = WS_ACT;
constexpr size_t WS_Q = WS_AG + 64 * MiB;
constexpr size_t WS_K = WS_Q + 32 * MiB;
constexpr size_t WS_V = WS_K + 32 * MiB;
constexpr size_t WS_MIX = WS_V + 32 * MiB;
constexpr size_t WS_WM = 805 * MiB;
constexpr size_t WM13_E = (size_t)2 * DFE * D * 2, WM2_E = (size_t)D * DFE * 2;
constexpr size_t WS_WM2 = WS_WM + 8 * WM13_E;
constexpr size_t WS_WS = 973 * MiB;
constexpr size_t WS_WIN = WS_WS;
constexpr size_t WS_WOUT = WS_WIN + 4 * (size_t)DIN * D * 2;
constexpr size_t WS_WG = WS_WOUT + 4 * (size_t)D * D * 2;
constexpr size_t WS_WP = WS_WG + 4 * (size_t)D * D * 2;
constexpr size_t WS_W13 = WS_WP + 4 * (size_t)D * DPLE * 2;
constexpr size_t WS_W2 = WS_W13 + 2 * (size_t)2 * DFF * D * 2;
constexpr size_t WS_END = WS_W2 + 2 * (size_t)D * DFF * 2;
static_assert(WS_ACT + (size_t)MAXT * 256 * DFE * 2 <= WS_WM && WS_Y + (size_t)MAXT * 256 * D * 2 <= WS_PBL && WS_MIX + 64 * MiB <= WS_WM && WS_WM2 + 8 * WM2_E <= WS_WS && WS_END <= 1044 * MiB, "d_ws map");
constexpr int CW_TMO = 0, CW_CODE = 1;
constexpr int CW_BAR = 4096;
constexpr int CW_CNT = 8192;

constexpr int RING_BYTES = 131072;
constexpr int TOK_OFF = RING_BYTES;
constexpr int TOK_BYTES = 32 * 512;
constexpr int MISC_OFF = TOK_OFF + TOK_BYTES;
constexpr int LDS_BYTES = MISC_OFF + 256;
static_assert(LDS_BYTES <= 160 * 1024, "LDS");

#define RLX_AGENT __ATOMIC_RELAXED, __HIP_MEMORY_SCOPE_AGENT
#define LDS_WAIT() asm volatile("s_waitcnt lgkmcnt(0)" ::: "memory")
#define VM_WAIT() asm volatile("s_waitcnt vmcnt(0)" ::: "memory")
__device__ __forceinline__ unsigned cvt_pk_bf16(float lo, float hi) { unsigned r; asm volatile("v_cvt_pk_bf16_f32 %0, %1, %2" : "=v"(r) : "v"(lo), "v"(hi)); return r; }
__device__ __forceinline__ float bf_lo(unsigned u) { return __uint_as_float(u << 16); }
__device__ __forceinline__ float bf_hi(unsigned u) { return __uint_as_float(u & 0xffff0000u); }
__device__ __forceinline__ float bf2f(bf16_t u) { return __uint_as_float((unsigned)u << 16); }
template <int X> __device__ __forceinline__ float swz_xor(float v) { return __int_as_float(__builtin_amdgcn_ds_swizzle(__float_as_int(v), (X << 10) | 0x1f)); }
__device__ __forceinline__ float xor32(float v) { auto r = __builtin_amdgcn_permlane32_swap(__float_as_uint(v), __float_as_uint(v), false, false); return __uint_as_float(r[0]) + __uint_as_float(r[1]); }
__device__ __forceinline__ float wave_sum(float v) {
    v += swz_xor<1>(v); v += swz_xor<2>(v); v += swz_xor<4>(v); v += swz_xor<8>(v); v += swz_xor<16>(v);
    return xor32(v);
}
template <int ID> __device__ __forceinline__ int opaque_lane() { int l; asm volatile("; opaque lane %c1\n\tv_mbcnt_lo_u32_b32 %0, -1, 0\n\tv_mbcnt_hi_u32_b32 %0, -1, %0" : "=v"(l) : "i"(ID)); return l; }
#define OPAQUE_LANE() opaque_lane<__COUNTER__>()
template <int ID> __device__ __forceinline__ int opaque_s(int x) { asm volatile("; opaque scalar %c1" : "+s"(x) : "i"(ID)); return x; }
#define OPAQUE_S(x) opaque_s<__COUNTER__>(x)
__device__ __forceinline__ float fast_sigmoid(float x) { return __builtin_amdgcn_rcpf(1.f + __builtin_amdgcn_exp2f(-LOG2E * x)); }

#define XB_TMO      128
#define XB_XCNT(j)  (256  + 64 * (j))
#define XB_XSUB(j)  (1280 + 64 * (j))
#define XB_XGEN(j)  (2304 + 64 * (j))
#define XB_TOP      3328
#define XB_TOPGEN   3392
#define XCD_BAR_WORDS 3456
#define XB_SPIN_CAP (1u << 18)
template <class P> __device__ __forceinline__ unsigned xb_ld(P p)              { return __hip_atomic_load(p, __ATOMIC_RELAXED, __HIP_MEMORY_SCOPE_AGENT); }
template <class P> __device__ __forceinline__ unsigned xb_add(P p, unsigned v) { return __hip_atomic_fetch_add(p, v, __ATOMIC_RELAXED, __HIP_MEMORY_SCOPE_AGENT); }
__device__ __forceinline__ unsigned xb_xcc_id() { return (unsigned)__builtin_amdgcn_s_getreg((3 << 11) | 20) & 0xFu; }
#define XB_SPIN(cond, bar) do { unsigned _sp = 0; while (cond) { __builtin_amdgcn_s_sleep(1); \
    if ((++_sp & 255u) == 0u) { if (xb_ld(&(bar)[XB_TMO])) break; if (_sp > XB_SPIN_CAP) { (void)xb_add(&(bar)[XB_TMO], 1u); break; } } } } while (0)
struct XcdBarrier { unsigned* bar; unsigned x; volatile LAS unsigned* st; };
__device__ __forceinline__ XcdBarrier xcd_barrier_post(unsigned* bar, volatile LAS unsigned* st) {
    XcdBarrier b; b.bar = bar; b.x = xb_xcc_id(); b.st = st;
    if (threadIdx.x == 0) (void)xb_add((GAS unsigned*)&bar[XB_XCNT(b.x)], 1u);
    return b;
}
__device__ __forceinline__ void xcd_barrier_complete(GAS unsigned* bar, unsigned x, unsigned& nloc, unsigned& nx) {
    const unsigned G = GRID;
    unsigned sum, cnt, mine, sp = 0u;
    for (;;) {
        sum = 0u; cnt = 0u; mine = 0u;
#pragma unroll
        for (unsigned j = 0; j < 16; ++j) { const unsigned c = xb_ld(&bar[XB_XCNT(j)]); sum += c; cnt += (c > 0u) ? 1u : 0u; mine = (j == x) ? c : mine; }
        if (sum == G) break;
        __builtin_amdgcn_s_sleep(1);
        if ((++sp & 255u) == 0u) { if (xb_ld(&bar[XB_TMO])) break; if (sp > XB_SPIN_CAP) { (void)xb_add(&bar[XB_TMO], 1u); break; } }
    }
    nloc = mine > 0u ? mine : 1u; nx = cnt > 0u ? cnt : 1u;
}
template <int ID> __device__ __forceinline__ void xcd_barrier(const XcdBarrier& b, const int tid) {
    asm volatile("s_waitcnt vmcnt(0)" ::: "memory");
    __syncthreads();
    if (tid == 0) {
        unsigned* bar0 = b.bar; asm volatile("; opaque bar %c1" : "+s"(bar0) : "i"(ID)); GAS unsigned* bar = (GAS unsigned*)bar0;
        __builtin_amdgcn_s_waitcnt(0);
        unsigned nloc = b.st[0], nx = b.st[1];
        if (nloc == 0u) { xcd_barrier_complete(bar, b.x, nloc, nx); b.st[0] = nloc; b.st[1] = nx; }
        const unsigned old = xb_add(&bar[XB_XSUB(b.x)], 1u);
        const unsigned gen = old / nloc;
        if (old + 1u == (gen + 1u) * nloc) {
            __builtin_amdgcn_fence(__ATOMIC_RELEASE, "agent");
            asm volatile("s_waitcnt vmcnt(0)" ::: "memory");
            const unsigned og = xb_add(&bar[XB_TOP], 1u);
            const unsigned tg = og / nx;
            if (og + 1u == (tg + 1u) * nx) xb_add(&bar[XB_TOPGEN], 1u);
            else XB_SPIN(xb_ld(&bar[XB_TOPGEN]) == tg, bar);
            __builtin_amdgcn_fence(__ATOMIC_ACQUIRE, "agent");
            xb_add(&bar[XB_XGEN(b.x)], 1u);
            asm volatile("s_waitcnt vmcnt(0)" ::: "memory");
        } else {
            XB_SPIN(xb_ld(&bar[XB_XGEN(b.x)]) == gen, bar);
            __builtin_amdgcn_fence(__ATOMIC_ACQUIRE, "agent");
            asm volatile("s_waitcnt vmcnt(0)" ::: "memory");
        }
    }
    __syncthreads();
}

namespace pg8 {
constexpr int BM = 256, BK = 64, HALF = 128, HTB = HALF * BK * 2, STAGE_BYTES = 8 * HTB, NXCD = 8, WGM = 8;
__host__ __device__ __forceinline__ int lds_byte(int r, int c) { const int st = (r >> 4) * 2 + (c >> 5), rr = r & 15, cc = c & 31, ob = rr * 64 + cc * 2; return st * 1024 + (ob ^ (((ob >> 9) & 1) << 5)); }
__host__ __device__ __forceinline__ void stage_rc(int b, int& R, int& C) { const int st = b / 1024, sb = b % 1024, swz = sb ^ (((sb >> 9) & 1) << 5); R = (st >> 1) * 16 + swz / 64; C = (st & 1) * 32 + (swz % 64) / 2; }
__host__ __device__ __forceinline__ int perm32(int rho) { const int n = rho >> 4, i = rho & 15; return 8 * (i >> 2) + 4 * n + (i & 3); }
struct Unit { int pm, pn; };
struct StaticOrder {
    int nM, nN, nwg, c; static constexpr int G = GRID;
    __device__ __forceinline__ void init(int nM_, int nN_, int, int c_) { nM = nM_; nN = nN_; nwg = nM * nN; c = c_; }
    __device__ __forceinline__ bool next(int i, Unit& u) const {
        const long L = (long)i * G + c; if (L >= nwg) return false;
        int wgid = (int)L; { const int q = nwg / NXCD, r = nwg % NXCD, xcd = wgid % NXCD, off = wgid / NXCD; wgid = (xcd < r ? xcd * (q + 1) : r * (q + 1) + (xcd - r) * q) + off; }
        const int nig = WGM * nN, gid = wgid / nig, fm = gid * WGM, gsz = (nM - fm) < WGM ? (nM - fm) : WGM;
        u.pm = fm + ((wgid % nig) % gsz); u.pn = (wgid % nig) / gsz; return true;
    }
};
struct DenseSched {
    static constexpr bool GATHER = false;
    StaticOrder o; const char* Bt; size_t tstepB;
    __device__ __forceinline__ bool next(int i, Unit& u) const { return o.next(i, u); }
    __device__ __forceinline__ const char* bptr(const Unit& u) const { return Bt + (size_t)u.pn * tstepB; }
};
template <bool GATHER_> struct MoeSched {
    static constexpr bool GATHER = GATHER_;
    StaticOrder o; const char* Bt; size_t tstepB, estepB; int t1, t2, t3, t4, t5, t6, t7;
    __device__ __forceinline__ bool next(int i, Unit& u) const { return o.next(i, u); }
    __device__ __forceinline__ int expert(int pm) const { return (pm >= t1) + (pm >= t2) + (pm >= t3) + (pm >= t4) + (pm >= t5) + (pm >= t6) + (pm >= t7); }
    __device__ __forceinline__ const char* bptr(const Unit& u) const { return Bt + (size_t)expert(u.pm) * estepB + (size_t)u.pn * tstepB; }
};

typedef f32x4 Acc[2][2][4][2];
struct EpiProj {
    static constexpr bool PERM = true;
    bf16_t *AG, *Q, *Kb, *V; const float* bias; float qscale;
    __device__ __forceinline__ void operator()(const Acc& acc, const Unit& u, int wr, int wc, int fr, int fq) const {
        const int pn = u.pn; bf16_t* base; int ldc, colt; float sc = 1.f;
        if (pn < 4) { base = AG; ldc = 1024; colt = pn * 256; }
        else if (pn < 6) { base = Q; ldc = 512; colt = (pn - 4) * 256; sc = qscale; }
        else if (pn < 8) { base = Kb; ldc = 512; colt = (pn - 6) * 256; }
        else { base = V; ldc = 512; colt = (pn - 8) * 256; }
        const int row0 = u.pm * BM + wr * 64 + fr, col0 = colt + wc * 32 + 8 * fq, bcol0 = pn * BM + wc * 32 + 8 * fq;
        f32x4 bv[2][2];
#pragma unroll
        for (int bj = 0; bj < 2; ++bj)
#pragma unroll
            for (int n = 0; n < 2; ++n) bv[bj][n] = *(const f32x4*)(bias + bcol0 + bj * HALF + 4 * n);
#pragma unroll
        for (int ai = 0; ai < 2; ++ai)
#pragma unroll
            for (int m = 0; m < 4; ++m) { bf16_t* rowp = base + (size_t)(row0 + ai * HALF + m * 16) * ldc + col0;
#pragma unroll
                for (int bj = 0; bj < 2; ++bj) { const f32x4 v0 = (acc[ai][bj][m][0] + bv[bj][0]) * sc, v1 = (acc[ai][bj][m][1] + bv[bj][1]) * sc;
                    u32x4 w; w.x = cvt_pk_bf16(v0[0], v0[1]); w.y = cvt_pk_bf16(v0[2], v0[3]); w.z = cvt_pk_bf16(v1[0], v1[1]); w.w = cvt_pk_bf16(v1[2], v1[3]);
                    *(u32x4*)(rowp + bj * HALF) = w; } }
    }
};
struct EpiBf16 {
    static constexpr bool PERM = true;
    bf16_t* O; int ldc;
    __device__ __forceinline__ void operator()(const Acc& acc, const Unit& u, int wr, int wc, int fr, int fq) const {
        const int row0 = u.pm * BM + wr * 64 + fr, col0 = u.pn * BM + wc * 32 + 8 * fq;
#pragma unroll
        for (int ai = 0; ai < 2; ++ai)
#pragma unroll
            for (int m = 0; m < 4; ++m) { bf16_t* rowp = O + (size_t)(row0 + ai * HALF + m * 16) * ldc + col0;
#pragma unroll
                for (int bj = 0; bj < 2; ++bj) { const f32x4 v0 = acc[ai][bj][m][0], v1 = acc[ai][bj][m][1];
                    u32x4 w; w.x = cvt_pk_bf16(v0[0], v0[1]); w.y = cvt_pk_bf16(v0[2], v0[3]); w.z = cvt_pk_bf16(v1[0], v1[1]); w.w = cvt_pk_bf16(v1[2], v1[3]);
                    *(u32x4*)(rowp + bj * HALF) = w; } }
    }
};
struct EpiSwiglu {
    static constexpr bool PERM = true;
    bf16_t* O; int ldc;
    __device__ __forceinline__ void operator()(const Acc& acc, const Unit& u, int wr, int wc, int fr, int fq) const {
        const int row0 = u.pm * BM + wr * 64 + fr, col0 = u.pn * HALF + wc * 32 + 8 * fq;
#pragma unroll
        for (int ai = 0; ai < 2; ++ai)
#pragma unroll
            for (int m = 0; m < 4; ++m) { bf16_t* rowp = O + (size_t)(row0 + ai * HALF + m * 16) * ldc + col0;
                f32x4 r[2];
#pragma unroll
                for (int n = 0; n < 2; ++n) { const f32x4 g = acc[ai][0][m][n], up = acc[ai][1][m][n];
#pragma unroll
                    for (int j = 0; j < 4; ++j) r[n][j] = g[j] * fast_sigmoid(g[j]) * up[j]; }
                u32x4 w; w.x = cvt_pk_bf16(r[0][0], r[0][1]); w.y = cvt_pk_bf16(r[0][2], r[0][3]); w.z = cvt_pk_bf16(r[1][0], r[1][1]); w.w = cvt_pk_bf16(r[1][2], r[1][3]);
                *(u32x4*)rowp = w; }
    }
};
struct EpiResid {
    static constexpr bool PERM = false;
    float* H; const float* bias; float alpha;
    __device__ __forceinline__ void operator()(const Acc& acc, const Unit& u, int wr, int wc, int fr, int fq) const {
        const int row0 = u.pm * BM + wr * 64 + fr, col0 = u.pn * BM + wc * 32 + 4 * fq;
        f32x4 bv[2][2];
#pragma unroll
        for (int bj = 0; bj < 2; ++bj)
#pragma unroll
            for (int n = 0; n < 2; ++n) bv[bj][n] = bias ? *(const f32x4*)(bias + col0 + bj * HALF + n * 16) : (f32x4){0.f, 0.f, 0.f, 0.f};
#pragma unroll
        for (int ai = 0; ai < 2; ++ai)
#pragma unroll
            for (int m = 0; m < 4; ++m) { float* rowp = H + (size_t)(row0 + ai * HALF + m * 16) * D + col0;
#pragma unroll
                for (int bj = 0; bj < 2; ++bj)
#pragma unroll
                    for (int n = 0; n < 2; ++n) { f32x4* p = (f32x4*)(rowp + bj * HALF + n * 16); const f32x4 h = *p; *p = h * alpha + acc[ai][bj][m][n] + bv[bj][n]; }
                if (m & 1) asm volatile("" ::: "memory"); }
    }
};
struct EpiPE {
    static constexpr bool PERM = false;
    bf16_t* O;
    __device__ __forceinline__ void operator()(const Acc& acc, const Unit& u, int wr, int wc, int fr, int fq) const {
        const int row0 = u.pm * BM + wr * 64 + fr, col0 = u.pn * BM + wc * 32 + 4 * fq;
#pragma unroll
        for (int ai = 0; ai < 2; ++ai)
#pragma unroll
            for (int m = 0; m < 4; ++m) { bf16_t* rowp = O + (size_t)(row0 + ai * HALF + m * 16) * D + col0;
#pragma unroll
                for (int bj = 0; bj < 2; ++bj)
#pragma unroll
                    for (int n = 0; n < 2; ++n) { const f32x4 v = acc[ai][bj][m][n]; u32x2 w; w.x = cvt_pk_bf16(v[0], v[1]); w.y = cvt_pk_bf16(v[2], v[3]); *(u32x2*)(rowp + bj * HALF + n * 16) = w; } }
    }
};
struct EpiGate {
    static constexpr bool PERM = false;
    float* H; const bf16_t* PE; const float* bias; float alpha;
    __device__ __forceinline__ void operator()(const Acc& acc, const Unit& u, int wr, int wc, int fr, int fq) const {
        const int row0 = u.pm * BM + wr * 64 + fr, col0 = u.pn * BM + wc * 32 + 4 * fq;
        f32x4 bv[2][2];
#pragma unroll
        for (int bj = 0; bj < 2; ++bj)
#pragma unroll
            for (int n = 0; n < 2; ++n) bv[bj][n] = *(const f32x4*)(bias + col0 + bj * HALF + n * 16);
#pragma unroll
        for (int ai = 0; ai < 2; ++ai)
#pragma unroll
            for (int m = 0; m < 4; ++m) { const size_t off = (size_t)(row0 + ai * HALF + m * 16) * D + col0;
#pragma unroll
                for (int bj = 0; bj < 2; ++bj)
#pragma unroll
                    for (int n = 0; n < 2; ++n) { f32x4* p = (f32x4*)(H + off + bj * HALF + n * 16); const f32x4 h = *p; const u32x2 pe = *(const u32x2*)(PE + off + bj * HALF + n * 16);
                        const f32x4 a = acc[ai][bj][m][n] + bv[bj][n]; f32x4 o;
                        o[0] = h[0] * alpha + fast_sigmoid(a[0]) * bf_lo(pe.x); o[1] = h[1] * alpha + fast_sigmoid(a[1]) * bf_hi(pe.x);
                        o[2] = h[2] * alpha + fast_sigmoid(a[2]) * bf_lo(pe.y); o[3] = h[3] * alpha + fast_sigmoid(a[3]) * bf_hi(pe.y); *p = o; }
                if (m & 1) asm volatile("" ::: "memory"); }
    }
};

template <int SITE, class Epi, class Sched>
__device__ __forceinline__ void gemm_phase(LAS unsigned char* lds, const char* Abase, const int K, const Sched& S, const Epi& E, const LAS unsigned short* tok, const int wid) {
    const int lane = opaque_lane<1000 + 2 * SITE>();
    const int tid = wid * 64 + lane, wr = wid >> 2, wc = wid & 3, fr = lane & 15, fq = lane >> 4;
    const int nt = K / BK;
    unsigned voffB[2], vC[2][2], vN[2][2]; int Rr[2], Cc[2];
#pragma unroll
    for (int i = 0; i < 2; ++i) { int R, C; stage_rc(tid * 16 + i * 8192, R, C); const int Rb = Epi::PERM ? ((R & ~31) + perm32(R & 31)) : R;
        voffB[i] = (unsigned)(Rb * K + C) * 2u; Rr[i] = R; Cc[i] = C;
        vC[0][i] = (unsigned)(R * K + C) * 2u; vC[1][i] = vC[0][i]; vN[0][i] = vC[0][i]; vN[1][i] = vC[0][i]; }
    const size_t kstep = (size_t)(BK * 2);
    const size_t hstep = (size_t)HALF * K * 2;
    const size_t tstep = 2 * hstep;
    const size_t ah = Sched::GATHER ? 0 : hstep;
    const unsigned ldsw = (unsigned)wid * 1024u;
    const int aoff = lds_byte(wr * 64 + fr, fq * 8), boff = lds_byte(wc * 32 + fr, fq * 8);
#define PG8_SA(b, h) (((b) * 2 + (h)) * HTB)
#define PG8_SB(b, h) ((4 + (b) * 2 + (h)) * HTB)
#define PG8_STAGE(bufoff, gbase, voff) do { _Pragma("unroll") for (int _i = 0; _i < 2; ++_i) \
        __builtin_amdgcn_global_load_lds((const unsigned*)((const char*)(gbase) + (voff)[_i]), (LAS unsigned*)(lds + (bufoff) + ldsw + _i * 8192), 16, 0, 0); } while (0)
#define PG8_LDA(dst, b, h) do { _Pragma("unroll") for (int m = 0; m < 4; ++m) _Pragma("unroll") for (int k = 0; k < 2; ++k) dst[m][k] = *(const LAS bf16x8*)(lds + PG8_SA(b, h) + aoff + m * 2048 + k * 1024); } while (0)
#define PG8_LDB(dst, b, h) do { _Pragma("unroll") for (int n = 0; n < 2; ++n) _Pragma("unroll") for (int k = 0; k < 2; ++k) dst[n][k] = *(const LAS bf16x8*)(lds + PG8_SB(b, h) + boff + n * 2048 + k * 1024); } while (0)
#define PG8_MMA(ai, bj, At, Bt) do { __builtin_amdgcn_s_setprio(1); _Pragma("unroll") for (int m = 0; m < 4; ++m) _Pragma("unroll") for (int n = 0; n < 2; ++n) _Pragma("unroll") for (int k = 0; k < 2; ++k) \
        acc[ai][bj][m][n] = __builtin_amdgcn_mfma_f32_16x16x32_bf16(Bt[n][k], At[m][k], acc[ai][bj][m][n], 0, 0, 0); __builtin_amdgcn_s_setprio(0); } while (0)
#define PG8_WAIT_V(n) asm volatile("s_waitcnt vmcnt(" #n ")" ::: "memory")
#define PG8_WAIT_L(n) asm volatile("s_waitcnt lgkmcnt(" #n ")" ::: "memory")
#define PG8_BAR __builtin_amdgcn_s_barrier()
#define PG8_SCHED __builtin_amdgcn_sched_barrier(0)
#define PG8_GATHER(dst, unit_i) do { _Pragma("unroll") for (int _h = 0; _h < 2; ++_h) _Pragma("unroll") for (int _i = 0; _i < 2; ++_i) \
        dst[_h][_i] = (unsigned)tok[(unit_i) * 256 + _h * HALF + Rr[_i]] * (unsigned)(K * 2) + (unsigned)(Cc[_i] * 2); } while (0)
    Unit cur, nxt; int ui = 0;
    if (!S.next(0, cur)) return;
    Acc acc;
#pragma unroll
    for (int a = 0; a < 2; ++a)
#pragma unroll
        for (int b = 0; b < 2; ++b)
#pragma unroll
            for (int m = 0; m < 4; ++m)
#pragma unroll
                for (int n = 0; n < 2; ++n) acc[a][b][m][n] = (f32x4){0.f, 0.f, 0.f, 0.f};
    bf16x8 At[4][2], B0[2][2], B1[2][2];
    if constexpr (Sched::GATHER) { PG8_GATHER(vC, 0); }
    const char* cA = Sched::GATHER ? Abase : Abase + (size_t)cur.pm * tstep; const char* cB = S.bptr(cur);
    PG8_STAGE(PG8_SB(0, 0), cB, voffB); PG8_STAGE(PG8_SB(0, 1), cB + hstep, voffB); PG8_STAGE(PG8_SA(0, 0), cA, vC[0]); PG8_STAGE(PG8_SA(0, 1), cA + ah, vC[1]);
    if (wr == 1) PG8_BAR;
    PG8_WAIT_V(2); PG8_BAR;
    PG8_STAGE(PG8_SB(1, 0), cB + kstep, voffB); PG8_STAGE(PG8_SA(1, 0), cA + kstep, vC[0]); PG8_STAGE(PG8_SB(1, 1), cB + hstep + kstep, voffB);
    PG8_WAIT_V(6); PG8_BAR;
    for (;;) {
        const bool has_next = S.next(ui + 1, nxt);
        const char* nA = (has_next && !Sched::GATHER) ? Abase + (size_t)nxt.pm * tstep : cA; const char* nB = has_next ? S.bptr(nxt) : cB;
        if constexpr (Sched::GATHER) { if (has_next) { PG8_GATHER(vN, ui + 1); } else { vN[0][0] = vC[0][0]; vN[0][1] = vC[0][1]; vN[1][0] = vC[1][0]; vN[1][1] = vC[1][1]; } }
        for (int t = 0; t < nt; t += 2) {
            const bool last = (t == nt - 2);
            const char* a1 = cA + (size_t)(t + 1) * kstep;
            const char* a2 = last ? nA : cA + (size_t)(t + 2) * kstep; const char* b2 = last ? nB : cB + (size_t)(t + 2) * kstep;
            const char* a3 = a2 + kstep; const char* b3 = b2 + kstep;
            unsigned vX[2][2];
            if constexpr (Sched::GATHER) { vX[0][0] = last ? vN[0][0] : vC[0][0]; vX[0][1] = last ? vN[0][1] : vC[0][1]; vX[1][0] = last ? vN[1][0] : vC[1][0]; vX[1][1] = last ? vN[1][1] : vC[1][1]; }
            else { vX[0][0] = vC[0][0]; vX[0][1] = vC[0][1]; vX[1][0] = vC[1][0]; vX[1][1] = vC[1][1]; }
            PG8_LDB(B0, 0, 0); PG8_LDB(B1, 0, 1); PG8_SCHED; PG8_LDA(At, 0, 0); PG8_STAGE(PG8_SA(1, 1), a1 + ah, vC[1]);
            PG8_WAIT_V(8); PG8_WAIT_L(0); PG8_BAR; PG8_MMA(0, 0, At, B0); PG8_MMA(0, 1, At, B1); PG8_BAR; PG8_SCHED;
            PG8_LDA(At, 0, 1); PG8_STAGE(PG8_SB(0, 0), b2, voffB); PG8_STAGE(PG8_SB(0, 1), b2 + hstep, voffB); PG8_STAGE(PG8_SA(0, 0), a2, vX[0]);
            PG8_WAIT_V(8); PG8_WAIT_L(0); PG8_BAR; PG8_MMA(1, 0, At, B0); PG8_MMA(1, 1, At, B1); PG8_BAR; PG8_SCHED;
            PG8_LDB(B0, 1, 0); PG8_LDB(B1, 1, 1); PG8_SCHED; PG8_LDA(At, 1, 0); PG8_STAGE(PG8_SA(0, 1), a2 + ah, vX[1]);
            PG8_WAIT_V(8); PG8_WAIT_L(0); PG8_BAR; PG8_MMA(0, 0, At, B0); PG8_MMA(0, 1, At, B1); PG8_BAR; PG8_SCHED;
            PG8_LDA(At, 1, 1); PG8_STAGE(PG8_SB(1, 0), b3, voffB); PG8_STAGE(PG8_SB(1, 1), b3 + hstep, voffB); PG8_STAGE(PG8_SA(1, 0), a3, vX[0]);
            PG8_WAIT_V(8); PG8_WAIT_L(0); PG8_BAR; PG8_MMA(1, 0, At, B0); PG8_MMA(1, 1, At, B1); PG8_BAR; PG8_SCHED;
        }
        if (wr == 0) PG8_BAR;
        { const int l2 = opaque_lane<1001 + 2 * SITE>(); E(acc, cur, wr, wc, l2 & 15, l2 >> 4); }
        if (!has_next) break;
#pragma unroll
        for (int a = 0; a < 2; ++a)
#pragma unroll
            for (int b = 0; b < 2; ++b)
#pragma unroll
                for (int m = 0; m < 4; ++m)
#pragma unroll
                    for (int n = 0; n < 2; ++n) acc[a][b][m][n] = (f32x4){0.f, 0.f, 0.f, 0.f};
        cur = nxt; cA = nA; cB = nB; ++ui;
        if constexpr (Sched::GATHER) { vC[0][0] = vN[0][0]; vC[0][1] = vN[0][1]; vC[1][0] = vN[1][0]; vC[1][1] = vN[1][1]; }
        if (wr == 1) PG8_BAR;
    }
    PG8_WAIT_V(0);
    PG8_BAR;
#undef PG8_SA
#undef PG8_SB
#undef PG8_STAGE
#undef PG8_LDA
#undef PG8_LDB
#undef PG8_MMA
#undef PG8_WAIT_V
#undef PG8_WAIT_L
#undef PG8_BAR
#undef PG8_SCHED
#undef PG8_GATHER
}
}

struct Args { const float* in[27]; float* out; unsigned char* ws; int ph_lo, ph_hi; };
typedef const __attribute__((address_space(4))) Args* CArgs;
template <int ID> __device__ __forceinline__ CArgs opaque_args() { CArgs p = (CArgs)__builtin_amdgcn_kernarg_segment_ptr(); asm volatile("; opaque args %c1" : "+s"(p) : "i"(ID)); return p; }
#define OPAQUE_ARGS() opaque_args<__COUNTER__>()
struct Frame { LAS unsigned char* lds; int vcu, wave; static constexpr int G = GRID; };
#define AIN(i) ((const float*)(const GAS float*)a->in[i])
#define PHASE_PREAMBLE() CArgs a = OPAQUE_ARGS(); unsigned char* const ws = (unsigned char*)(GAS unsigned char*)a->ws; const int lane = OPAQUE_LANE(), wave = OPAQUE_S(F.wave), vcu = OPAQUE_S(F.vcu), tid = wave * 64 + lane; (void)ws; (void)tid; (void)vcu
constexpr int NPH = 1 + DEPTH * 7;

__device__ __forceinline__ void tr_item(const float* W, int N, bf16_t* WT, int ldt, int k0, int n0, int orow0, LAS float* scr, int lane) {
#pragma unroll 8
    for (int i = 0; i < 32; ++i) { const int kk = 2 * i + (lane >> 5); scr[kk * 33 + (lane & 31)] = W[(size_t)(k0 + kk) * N + n0 + (lane & 31)]; }
    LDS_WAIT(); asm volatile("" ::: "memory");
    const int c = lane & 7;
#pragma unroll
    for (int j = 0; j < 4; ++j) { const int n = (lane >> 3) + 8 * j; const LAS float* s = scr + (8 * c) * 33 + n;
        u32x4 o; o.x = cvt_pk_bf16(s[0 * 33], s[1 * 33]); o.y = cvt_pk_bf16(s[2 * 33], s[3 * 33]); o.z = cvt_pk_bf16(s[4 * 33], s[5 * 33]); o.w = cvt_pk_bf16(s[6 * 33], s[7 * 33]);
        *(u32x4*)(WT + (size_t)(orow0 + n) * ldt + k0 + 8 * c) = o; }
    LDS_WAIT(); asm volatile("" ::: "memory");
}
__device__ __forceinline__ void cvt_class_item(const float* W0, int K, int N, bf16_t* WT0, size_t wt_stride  , int il, int r, LAS float* scr, int lane) {
    const int nblk = N / 32, per = (K / 64) * nblk, mat = r / per, it = r % per, kb = it / nblk, nb = it % nblk, n0 = 32 * nb;
    const int orow0 = il == 0 ? n0 : ((n0 >> 7) * 256 + (n0 & 127) + (il == 2 ? 128 : 0));
    tr_item(W0 + (size_t)mat * K * N, N, WT0 + (size_t)mat * wt_stride, K, 64 * kb, n0, orow0, scr, lane);
}
__device__ __forceinline__ void cvt_static_weights(const Frame& F, CArgs a, unsigned char* ws, int lane, int wave, int vcu) {
    LAS float* scr = (LAS float*)(F.lds + wave * 16384);
    const int gw = vcu * NWAVES + wave, NGW = F.G * NWAVES;
    constexpr int I_IN = 4 * (D / 64) * (DIN / 32), I_OUT = 4 * (D / 64) * (D / 32), I_G = I_OUT, I_P = 4 * (DPLE / 64) * (D / 32), I_F1 = 2 * (D / 64) * (DFF / 32), I_F2 = 2 * (DFF / 64) * (D / 32);
    constexpr int NIT = I_IN + I_OUT + I_G + I_P + 2 * I_F1 + I_F2;
    for (int it = gw; it < NIT; it += NGW) {
        int r = it;
        if (r < I_IN) { cvt_class_item(AIN(4), D, DIN, (bf16_t*)(ws + WS_WIN), (size_t)DIN * D, 0, r, scr, lane); continue; } r -= I_IN;
        if (r < I_OUT) { cvt_class_item(AIN(11), D, D, (bf16_t*)(ws + WS_WOUT), (size_t)D * D, 0, r, scr, lane); continue; } r -= I_OUT;
        if (r < I_G) { cvt_class_item(AIN(23), D, D, (bf16_t*)(ws + WS_WG), (size_t)D * D, 0, r, scr, lane); continue; } r -= I_G;
        if (r < I_P) { cvt_class_item(AIN(22), DPLE, D, (bf16_t*)(ws + WS_WP), (size_t)D * DPLE, 0, r, scr, lane); continue; } r -= I_P;
        if (r < I_F1) { cvt_class_item(AIN(15), D, DFF, (bf16_t*)(ws + WS_W13), (size_t)2 * DFF * D, 1, r, scr, lane); continue; } r -= I_F1;
        if (r < I_F1) { cvt_class_item(AIN(16), D, DFF, (bf16_t*)(ws + WS_W13), (size_t)2 * DFF * D, 2, r, scr, lane); continue; } r -= I_F1;
        cvt_class_item(AIN(17), DFF, D, (bf16_t*)(ws + WS_W2), (size_t)D * DFF, 0, r, scr, lane);
    }
}
__device__ __forceinline__ void cvt_moe_weights(const Frame& F, CArgs a, unsigned char* ws, int lane, int wave, int vcu, int j) {
    LAS float* scr = (LAS float*)(F.lds + wave * 16384);
    const int gw = vcu * NWAVES + wave, NGW = F.G * NWAVES;
    constexpr int I_1 = NE * (D / 64) * (DFE / 32), I_2 = NE * (DFE / 64) * (D / 32);
    const size_t wo = (size_t)j * NE * D * DFE;
    for (int it = gw; it < 2 * I_1 + I_2; it += NGW) {
        int r = it;
        if (r < I_1) { cvt_class_item(AIN(19) + wo, D, DFE, (bf16_t*)(ws + WS_WM), WM13_E / 2, 1, r, scr, lane); continue; } r -= I_1;
        if (r < I_1) { cvt_class_item(AIN(20) + wo, D, DFE, (bf16_t*)(ws + WS_WM), WM13_E / 2, 2, r, scr, lane); continue; } r -= I_1;
        cvt_class_item(AIN(21) + wo, DFE, D, (bf16_t*)(ws + WS_WM2), WM2_E / 2, 0, r, scr, lane);
    }
}

__device__ __forceinline__ void ln_row(f32x4 (&v)[4], const f32x4 (&g)[4], const f32x4 (&b)[4]) {
    float s = 0.f;
#pragma unroll
    for (int j = 0; j < 4; ++j) s += (v[j][0] + v[j][1]) + (v[j][2] + v[j][3]);
    const float mean = wave_sum(s) * (1.f / D); float q = 0.f;
#pragma unroll
    for (int j = 0; j < 4; ++j) { v[j] = v[j] - mean; q += (v[j][0] * v[j][0] + v[j][1] * v[j][1]) + (v[j][2] * v[j][2] + v[j][3] * v[j][3]); }
    const float rstd = 1.f / sqrtf(wave_sum(q) * (1.f / D) + LN_EPS);
#pragma unroll
    for (int j = 0; j < 4; ++j) v[j] = v[j] * rstd * g[j] + b[j];
}
__device__ __forceinline__ void store_row(const f32x4 (&v)[4], float* h32row, bf16_t* hbrow, int lane) {
#pragma unroll
    for (int j = 0; j < 4; ++j) {
        if (h32row) *(f32x4*)(h32row + 4 * lane + 256 * j) = v[j];
        if (hbrow) { u32x2 w; w.x = cvt_pk_bf16(v[j][0], v[j][1]); w.y = cvt_pk_bf16(v[j][2], v[j][3]); *(u32x2*)(hbrow + 4 * lane + 256 * j) = w; }
    }
}

__device__ __forceinline__ void ph_prologue(const Frame& F) {
    PHASE_PREAMBLE();
    cvt_static_weights(F, a, ws, lane, wave, vcu);
    cvt_moe_weights(F, a, ws, lane, wave, vcu, 0);
    const int gw = vcu * NWAVES + wave, NGW = F.G * NWAVES;
    f32x4 g[4], b[4];
#pragma unroll
    for (int j = 0; j < 4; ++j) { g[j] = *(const f32x4*)(AIN(2) + 4 * lane + 256 * j); b[j] = *(const f32x4*)(AIN(3) + 4 * lane + 256 * j); }
    float* H32 = (float*)(ws + WS_H32); bf16_t* HB = (bf16_t*)(ws + WS_HB);
    for (int m = gw; m < M; m += NGW) {
        f32x4 v[4];
#pragma unroll
        for (int j = 0; j < 4; ++j) v[j] = *(const f32x4*)(AIN(0) + (size_t)m * D + 4 * lane + 256 * j);
        ln_row(v, g, b);
        store_row(v, H32 + (size_t)m * D, HB + (size_t)m * D, lane);
    }
}

__device__ __forceinline__ void ph_conv(const Frame& F, int layer) {
    PHASE_PREAMBLE();
    const bf16_t* AG = (const bf16_t*)(ws + WS_AG); bf16_t* MIX = (bf16_t*)(ws + WS_MIX);
    LAS float* U = (LAS float*)F.lds;
    const int c = tid;
    const float* cw = AIN(6) + (size_t)layer * CONV_K * CONV_CH; const float cb = AIN(7)[layer * CONV_CH + c];
    float w[CONV_K];
#pragma unroll
    for (int k = 0; k < CONV_K; ++k) w[k] = cw[k * CONV_CH + c];
    const float* lg = AIN(8) + layer * CONV_CH; const float* lb = AIN(9) + layer * CONV_CH;
    for (int unit = vcu; unit < M / 32; unit += F.G) {
        const int t0 = unit * 32, bt = t0 / SEQ, tt0 = t0 % SEQ;
        for (int r = 0; r < 62; ++r) {
            const int ts = tt0 + r - 15; float u = 0.f;
            if (ts >= 0 && ts < SEQ) { const bf16_t* p = AG + ((size_t)bt * SEQ + ts) * 1024; const float av = bf2f(p[c]), gv = bf2f(p[CONV_CH + c]); u = av * fast_sigmoid(gv); }
            U[r * CONV_CH + c] = u;
        }
        __syncthreads();
        float y[32];
#pragma unroll
        for (int t = 0; t < 32; ++t) y[t] = cb;
#pragma unroll
        for (int r = 0; r < 62; ++r) { const float x = U[r * CONV_CH + c];
#pragma unroll
            for (int t = 0; t < 32; ++t) if (r - t >= 0 && r - t < CONV_K) y[t] += w[r - t] * x; }
        __syncthreads();
#pragma unroll
        for (int t = 0; t < 32; ++t) U[t * CONV_CH + c] = y[t];
        __syncthreads();
#pragma unroll
        for (int i = 0; i < 4; ++i) { const int t = wave * 4 + i; float v[8]; float s = 0.f;
#pragma unroll
            for (int j = 0; j < 8; ++j) { v[j] = U[t * CONV_CH + lane + 64 * j]; s += v[j]; }
            const float mean = wave_sum(s) * (1.f / CONV_CH); float q = 0.f;
#pragma unroll
            for (int j = 0; j < 8; ++j) { v[j] -= mean; q += v[j] * v[j]; }
            const float rstd = 1.f / sqrtf(wave_sum(q) * (1.f / CONV_CH) + LN_EPS);
#pragma unroll
            for (int j = 0; j < 8; ++j) { float o = v[j] * rstd * lg[lane + 64 * j] + lb[lane + 64 * j]; o = o * fast_sigmoid(o);
                MIX[(size_t)(t0 + t) * 1024 + lane + 64 * j] = (bf16_t)(cvt_pk_bf16(o, 0.f) & 0xffffu); } }
        __syncthreads();
    }
}
__device__ __forceinline__ void ph_attn_simple(const Frame& F, int layer) {
    PHASE_PREAMBLE();
    const bf16_t* Q = (const bf16_t*)(ws + WS_Q); const bf16_t* Kb = (const bf16_t*)(ws + WS_K); const bf16_t* V = (const bf16_t*)(ws + WS_V); bf16_t* MIX = (bf16_t*)(ws + WS_MIX);
    const float* rpb = AIN(10) + (size_t)layer * NH * 15 * 31;
    const int gw = vcu * NWAVES + wave, NGW = F.G * NWAVES;
    for (int w = gw; w < M * NH; w += NGW) {
        const int t = w / NH, h = w % NH;
        const int bt = t / SEQ, tt = t % SEQ, r = tt / GRID_W, c = tt % GRID_W;
        int r0 = r - 4; r0 = r0 < 0 ? 0 : (r0 > ROWS - 8 ? ROWS - 8 : r0);
        int c0 = c - 8; c0 = c0 < 0 ? 0 : (c0 > GRID_W - 16 ? GRID_W - 16 : c0);
        const float q = bf2f(Q[(size_t)t * 512 + h * HD + lane]);
        float mx = -INFINITY, l = 0.f, acc = 0.f;
        for (int i = 0; i < 8; ++i)
            for (int j = 0; j < 16; ++j) {
                const int kr = r0 + i, kc = c0 + j; const size_t kt = (size_t)bt * SEQ + kr * GRID_W + kc;
                const float kv = bf2f(Kb[kt * 512 + h * HD + lane]), vv = bf2f(V[kt * 512 + h * HD + lane]);
                const float s = wave_sum(q * kv) + LOG2E * rpb[(h * 15 + (kr - r + 7)) * 31 + (kc - c + 15)];
                const float nm = fmaxf(mx, s), f = __builtin_amdgcn_exp2f(mx - nm), p = __builtin_amdgcn_exp2f(s - nm);
                l = l * f + p; acc = acc * f + p * vv; mx = nm;
            }
        MIX[(size_t)t * 1024 + CONV_CH + h * HD + lane] = (bf16_t)(cvt_pk_bf16(acc / l, 0.f) & 0xffffu);
    }
}

typedef short v4i16_t __attribute__((ext_vector_type(4)));
constexpr int ATT_TAB_FLOATS = NH * 15 * 32, ATT_VROW = 160, ATT_VBUF = 32 * ATT_VROW;
__device__ __forceinline__ void ph_attn(const Frame& F, int layer) {
    PHASE_PREAMBLE();
    const bf16_t* Q = (const bf16_t*)(ws + WS_Q); const bf16_t* Kb = (const bf16_t*)(ws + WS_K); const bf16_t* V = (const bf16_t*)(ws + WS_V); bf16_t* MIX = (bf16_t*)(ws + WS_MIX);
    LAS float* TAB = (LAS float*)F.lds;
    {   const float* rpb = AIN(10) + (size_t)layer * NH * 15 * 31;
        for (int i = tid; i < ATT_TAB_FLOATS; i += NWAVES * 64) { const int hd = i >> 5, dc = i & 31; TAB[i] = dc < 31 ? LOG2E * rpb[hd * 31 + dc] : -INFINITY; }
        __syncthreads(); }
    LAS unsigned char* vbuf = F.lds + ATT_TAB_FLOATS * 4 + wave * (2 * ATT_VBUF);
    const int fr = lane & 15, fq = lane >> 4, h = wave;
    const int vrd = (4 * fq + ((lane & 15) >> 2)) * ATT_VROW + 8 * (lane & 3);
    for (int u = 0; u < (M / GRID_W) / GRID; ++u) {
        const int br = vcu * ((M / GRID_W) / GRID) + u, b = br / ROWS, r = br % ROWS;
        int r0 = r - 4; r0 = r0 < 0 ? 0 : (r0 > ROWS - 8 ? ROWS - 8 : r0);
        const int drb = r0 - r + 7;
#pragma unroll 1
        for (int j = 0; j < 4; ++j) {
            const int band0 = j == 0 ? 0 : (j == 1 ? 8 : (j == 2 ? 24 : 32));
            const int qc = 16 * j + fr; int win0 = qc - 8; win0 = win0 < 0 ? 0 : (win0 > GRID_W - 16 ? GRID_W - 16 : win0);
            const size_t qtok = (size_t)b * SEQ + r * GRID_W + qc;
            bf16x8 qf[2];
#pragma unroll
            for (int kk = 0; kk < 2; ++kk) qf[kk] = *(const bf16x8*)(Q + qtok * 512 + h * HD + kk * 32 + 8 * fq);
            int tix[2][4];
#pragma unroll
            for (int th = 0; th < 2; ++th)
#pragma unroll
                for (int rg = 0; rg < 4; ++rg) { const int kc = band0 + 16 * th + 4 * fq + rg; const bool ok = kc >= win0 && kc < win0 + 16; tix[th][rg] = (h * 15 + drb) * 32 + (ok ? kc - qc + 15 : 31); }
            const size_t ktok0 = (size_t)b * SEQ + r0 * GRID_W + band0;
            const bf16_t* kp = Kb + (ktok0 + fr) * 512 + h * HD + 8 * fq;
            const bf16_t* vp = V + (ktok0 + (lane >> 3)) * 512 + h * HD + (lane & 7) * 8;
            const int vwr = (lane >> 3) * ATT_VROW + (lane & 7) * 16;
            u32x4 vn[4];
#pragma unroll
            for (int x = 0; x < 4; ++x) vn[x] = *(const u32x4*)(vp + (size_t)(x * 8) * 512);
            f32x4 s[8][2];
#pragma unroll
            for (int i = 0; i < 8; ++i)
#pragma unroll
                for (int th = 0; th < 2; ++th) {
                    const bf16x8 k0 = *(const bf16x8*)(kp + (size_t)(i * GRID_W + th * 16) * 512), k1 = *(const bf16x8*)(kp + (size_t)(i * GRID_W + th * 16) * 512 + 32);
                    f32x4 a = __builtin_amdgcn_mfma_f32_16x16x32_bf16(k0, qf[0], (f32x4){0.f, 0.f, 0.f, 0.f}, 0, 0, 0);
                    s[i][th] = __builtin_amdgcn_mfma_f32_16x16x32_bf16(k1, qf[1], a, 0, 0, 0); }
#pragma unroll
            for (int x = 0; x < 4; ++x) *(LAS u32x4*)(vbuf + vwr + x * 8 * ATT_VROW) = vn[x];
            float mx = -INFINITY;
#pragma unroll
            for (int i = 0; i < 8; ++i)
#pragma unroll
                for (int th = 0; th < 2; ++th)
#pragma unroll
                    for (int rg = 0; rg < 4; ++rg) { s[i][th][rg] += TAB[tix[th][rg] + i * 32]; mx = fmaxf(mx, s[i][th][rg]); }
            mx = fmaxf(mx, swz_xor<16>(mx));
            { auto rr = __builtin_amdgcn_permlane32_swap(__float_as_uint(mx), __float_as_uint(mx), false, false); mx = fmaxf(__uint_as_float(rr[0]), __uint_as_float(rr[1])); }
            float l = 0.f;
#pragma unroll
            for (int i = 0; i < 8; ++i)
#pragma unroll
                for (int th = 0; th < 2; ++th)
#pragma unroll
                    for (int rg = 0; rg < 4; ++rg) { const float pv = __builtin_amdgcn_exp2f(s[i][th][rg] - mx); s[i][th][rg] = pv; l += pv; }
            l += swz_xor<16>(l); l = xor32(l);
            f32x4 o[4];
#pragma unroll
            for (int db = 0; db < 4; ++db) o[db] = (f32x4){0.f, 0.f, 0.f, 0.f};
#pragma unroll
            for (int i = 0; i < 8; ++i) {
                if (i + 1 < 8) {
#pragma unroll
                    for (int x = 0; x < 4; ++x) vn[x] = *(const u32x4*)(vp + (size_t)((i + 1) * GRID_W + x * 8) * 512); }
                u32x4 pw; pw.x = cvt_pk_bf16(s[i][0][0], s[i][0][1]); pw.y = cvt_pk_bf16(s[i][0][2], s[i][0][3]); pw.z = cvt_pk_bf16(s[i][1][0], s[i][1][1]); pw.w = cvt_pk_bf16(s[i][1][2], s[i][1][3]);
                const bf16x8 pf = __builtin_bit_cast(bf16x8, pw);
                LAS unsigned char* vb = vbuf + (i & 1) * ATT_VBUF + vrd;
#pragma unroll
                for (int db = 0; db < 4; ++db) {
                    const v4i16_t t0 = __builtin_amdgcn_ds_read_tr16_b64_v4i16((LAS v4i16_t*)(vb + 32 * db)), t1 = __builtin_amdgcn_ds_read_tr16_b64_v4i16((LAS v4i16_t*)(vb + 16 * ATT_VROW + 32 * db));
                    const bf16x8 vf = (bf16x8){t0[0], t0[1], t0[2], t0[3], t1[0], t1[1], t1[2], t1[3]};
                    o[db] = __builtin_amdgcn_mfma_f32_16x16x32_bf16(vf, pf, o[db], 0, 0, 0); }
                if (i + 1 < 8) {
#pragma unroll
                    for (int x = 0; x < 4; ++x) *(LAS u32x4*)(vbuf + ((i + 1) & 1) * ATT_VBUF + vwr + x * 8 * ATT_VROW) = vn[x]; }
            }
            const float inv = 1.f / l;
            bf16_t* op = MIX + qtok * 1024 + CONV_CH + h * HD + 4 * fq;
#pragma unroll
            for (int db = 0; db < 4; ++db) { u32x2 w; w.x = cvt_pk_bf16(o[db][0] * inv, o[db][1] * inv); w.y = cvt_pk_bf16(o[db][2] * inv, o[db][3] * inv); *(u32x2*)(op + 16 * db) = w; }
        }
    }
    __syncthreads();
}

__device__ __forceinline__ void ph_ln1(const Frame& F, int layer) {
    PHASE_PREAMBLE();
    const bool moe = (layer & 1) != 0; const int jm = layer >> 1;
    float* H32 = (float*)(ws + WS_H32); bf16_t* HB = (bf16_t*)(ws + WS_HB);
    LAS float* WR = (LAS float*)F.lds;
    LAS unsigned* lcnt = (LAS unsigned*)(F.lds + 32768);
    if (moe) {
        const float* wr = AIN(18) + (size_t)jm * D * NE;
        for (int i = tid; i < D * NE / 4; i += NWAVES * 64) ((LAS f32x4*)WR)[i] = ((const f32x4*)wr)[i];
        if (tid < 16) lcnt[tid] = 0u;
        __syncthreads();
    }
    f32x4 g[4], b[4];
#pragma unroll
    for (int j = 0; j < 4; ++j) { g[j] = *(const f32x4*)(AIN(13) + layer * D + 4 * lane + 256 * j); b[j] = *(const f32x4*)(AIN(14) + layer * D + 4 * lane + 256 * j); }
    const int gw = vcu * NWAVES + wave;
    int me0 = 0, me1 = 0; float mg0 = 0.f, mg1 = 0.f;
    for (int i = 0; i < 16; ++i) {
        const int m = gw * 16 + i;
        f32x4 v[4];
#pragma unroll
        for (int j = 0; j < 4; ++j) v[j] = *(const f32x4*)(H32 + (size_t)m * D + 4 * lane + 256 * j);
        ln_row(v, g, b);
        store_row(v, H32 + (size_t)m * D, HB + (size_t)m * D, lane);
        if (moe) {
            float lgt[NE];
#pragma unroll
            for (int e = 0; e < NE; ++e) lgt[e] = 0.f;
#pragma unroll
            for (int j = 0; j < 4; ++j)
#pragma unroll
                for (int k = 0; k < 4; ++k) { const int d = 4 * lane + 256 * j + k; const f32x4 w0 = *(const LAS f32x4*)(WR + d * 8), w1 = *(const LAS f32x4*)(WR + d * 8 + 4); const float x = v[j][k];
                    lgt[0] += x * w0[0]; lgt[1] += x * w0[1]; lgt[2] += x * w0[2]; lgt[3] += x * w0[3]; lgt[4] += x * w1[0]; lgt[5] += x * w1[1]; lgt[6] += x * w1[2]; lgt[7] += x * w1[3]; }
#pragma unroll
            for (int e = 0; e < NE; ++e) lgt[e] = wave_sum(lgt[e]);
            int i0 = 0; float v0 = lgt[0];
#pragma unroll
            for (int e = 1; e < NE; ++e) if (lgt[e] > v0) { v0 = lgt[e]; i0 = e; }
            int i1 = -1; float v1 = -INFINITY;
#pragma unroll
            for (int e = 0; e < NE; ++e) if (e != i0 && lgt[e] > v1) { v1 = lgt[e]; i1 = e; }
            const float g1 = 1.f / (1.f + __expf(v0 - v1)), g0 = 1.f - g1;
            if (lane == i) { me0 = i0; me1 = i1; mg0 = g0; mg1 = g1; }
        }
    }
    if (moe) {
        gu32* cnt = ((gu32*)(ws + WS_CTL)) + CW_CNT + jm * 8 * 64;
        const int oe1 = __builtin_amdgcn_ds_bpermute((lane & 15) << 2, me1);
        const bool valid = lane < 32; const int k = lane >> 4; const int mye = valid ? (k ? oe1 : me0) : -1;
        unsigned slot = 0;
#pragma unroll
        for (int e = 0; e < NE; ++e) { const unsigned long long mask = __ballot(mye == e); const unsigned c = (unsigned)__popcll(mask);
            unsigned wb = 0; if (lane == 0 && c) wb = __hip_atomic_fetch_add(lcnt + e, c, __ATOMIC_RELAXED, __HIP_MEMORY_SCOPE_WORKGROUP);
            wb = (unsigned)__builtin_amdgcn_readfirstlane((int)wb);
            if (mye == e) slot = wb + (unsigned)__popcll(mask & ((1ull << lane) - 1ull)); }
        __syncthreads();
        if (tid < NE) lcnt[8 + tid] = __hip_atomic_fetch_add(cnt + 64 * tid, lcnt[tid], RLX_AGENT);
        __syncthreads();
        if (valid) {
            slot += lcnt[8 + mye];
            const int row = gw * 16 + (lane & 15);
            ((unsigned*)(ws + WS_LIST))[(size_t)mye * M + slot] = (unsigned)row;
            ((unsigned*)(ws + WS_TOKS))[2 * row + k] = slot;
            if (k == 0) { ((unsigned*)(ws + WS_TOKE))[row] = (unsigned)me0 | ((unsigned)me1 << 8); ((float*)(ws + WS_TOKG))[2 * row] = mg0; ((float*)(ws + WS_TOKG))[2 * row + 1] = mg1; }
        }
    }
    const float* P = AIN(1) + (size_t)layer * M * DPLE + (size_t)gw * 16 * DPLE; bf16_t* PB = (bf16_t*)(ws + WS_PBL) + (size_t)gw * 16 * DPLE;
#pragma unroll 4
    for (int i = 0; i < 16; ++i) { const f32x4 x = *(const f32x4*)(P + i * 256 + 4 * lane); u32x2 w; w.x = cvt_pk_bf16(x[0], x[1]); w.y = cvt_pk_bf16(x[2], x[3]); *(u32x2*)(PB + i * 256 + 4 * lane) = w; }
}

struct MoeTiles { int cnt[NE]; int ts[NE + 1]; };
__device__ __forceinline__ void moe_tiles(unsigned char* ws, int jm, MoeTiles& T) {
    gu32* cnt = ((gu32*)(ws + WS_CTL)) + CW_CNT + jm * 8 * 64; int s = 0;
#pragma unroll
    for (int e = 0; e < NE; ++e) { const int c = __builtin_amdgcn_readfirstlane((int)__hip_atomic_load(cnt + 64 * e, RLX_AGENT)); T.cnt[e] = c; T.ts[e] = s; s += (c + 255) >> 8; }
    T.ts[NE] = s;
}

__device__ __forceinline__ void ph_ln2(const Frame& F, int layer) {
    PHASE_PREAMBLE();
    const bool moe = (layer & 1) != 0; const int jm = layer >> 1;
    float* H32 = (float*)(ws + WS_H32); bf16_t* HB = (bf16_t*)(ws + WS_HB); const bf16_t* Y = (const bf16_t*)(ws + WS_Y);
    MoeTiles T; if (moe) moe_tiles(ws, jm, T);
    f32x4 g[4], b[4];
#pragma unroll
    for (int j = 0; j < 4; ++j) { g[j] = *(const f32x4*)(AIN(25) + layer * D + 4 * lane + 256 * j); b[j] = *(const f32x4*)(AIN(26) + layer * D + 4 * lane + 256 * j); }
    const int gw = vcu * NWAVES + wave, NGW = F.G * NWAVES;
    for (int m = gw; m < M; m += NGW) {
        f32x4 v[4];
#pragma unroll
        for (int j = 0; j < 4; ++j) v[j] = *(const f32x4*)(H32 + (size_t)m * D + 4 * lane + 256 * j);
        if (moe) {
            const unsigned ee = ((const unsigned*)(ws + WS_TOKE))[m]; const int e0 = ee & 0xff, e1 = (ee >> 8) & 0xff;
            const unsigned s0 = ((const unsigned*)(ws + WS_TOKS))[2 * m], s1 = ((const unsigned*)(ws + WS_TOKS))[2 * m + 1];
            const float g0 = ((const float*)(ws + WS_TOKG))[2 * m], g1 = ((const float*)(ws + WS_TOKG))[2 * m + 1];
            int t0 = 0, t1 = 0;
#pragma unroll
            for (int e = 0; e < NE; ++e) { if (e == e0) t0 = T.ts[e]; if (e == e1) t1 = T.ts[e]; }
            const bf16_t* y0 = Y + ((size_t)t0 * 256 + s0) * D; const bf16_t* y1 = Y + ((size_t)t1 * 256 + s1) * D;
#pragma unroll
            for (int j = 0; j < 4; ++j) { const u32x2 p0 = *(const u32x2*)(y0 + 4 * lane + 256 * j), p1 = *(const u32x2*)(y1 + 4 * lane + 256 * j);
                v[j][0] += g0 * bf_lo(p0.x) + g1 * bf_lo(p1.x); v[j][1] += g0 * bf_hi(p0.x) + g1 * bf_hi(p1.x);
                v[j][2] += g0 * bf_lo(p0.y) + g1 * bf_lo(p1.y); v[j][3] += g0 * bf_hi(p0.y) + g1 * bf_hi(p1.y); }
        }
        ln_row(v, g, b);
        if (layer == DEPTH - 1) store_row(v, ((float*)(GAS float*)a->out) + (size_t)m * D, nullptr, lane);
        else store_row(v, H32 + (size_t)m * D, HB + (size_t)m * D, lane);
    }
}

__global__ void __launch_bounds__(NWAVES * 64, 2) mk_fwd(Args args) {
    extern __shared__ __attribute__((aligned(16))) unsigned char lds[];
    Frame F;
    F.lds = (LAS unsigned char*)lds;
    volatile LAS unsigned* MISC = (volatile LAS unsigned*)(F.lds + MISC_OFF);
    F.wave = __builtin_amdgcn_readfirstlane((int)(threadIdx.x >> 6));
    { const int bx = blockIdx.x; F.vcu = (bx % 8) * (GRID / 8) + bx / 8; }
    if (threadIdx.x < 64) MISC[threadIdx.x] = 0u;
    __syncthreads();
    const int lo = args.ph_lo, hi = args.ph_hi;
    XcdBarrier bar; bar.bar = (unsigned*)(args.ws + WS_CTL) + CW_BAR; bar.x = 0; bar.st = nullptr;
    if (hi - lo > 1) bar = xcd_barrier_post((unsigned*)(args.ws + WS_CTL) + CW_BAR, MISC + 8);
#define IN(k) (lo <= (k) && (k) < hi)
#define SEAM(k) do { if (IN(k) && IN((k) + 1)) xcd_barrier<__COUNTER__>(bar, F.wave * 64 + OPAQUE_LANE()); } while (0)
    const LAS unsigned short* tok = (const LAS unsigned short*)(F.lds + TOK_OFF);
    const int c = (int)blockIdx.x;

    if (IN(0)) { ph_prologue(F); } SEAM(0);

    for (int layer = 0; layer < DEPTH; ++layer) {
        const int pb = 1 + layer * 7; const int jd = layer >> 1;
        if (IN(pb + 0)) {
            CArgs a = OPAQUE_ARGS(); unsigned char* const ws = (unsigned char*)(GAS unsigned char*)a->ws;
            pg8::DenseSched S; S.o.init(M / 256, DIN / 256, F.G, OPAQUE_S(c)); S.Bt = (const char*)(ws + WS_WIN) + (size_t)layer * DIN * D * 2; S.tstepB = (size_t)256 * D * 2;
            pg8::EpiProj E{(bf16_t*)(ws + WS_AG), (bf16_t*)(ws + WS_Q), (bf16_t*)(ws + WS_K), (bf16_t*)(ws + WS_V), AIN(5) + layer * DIN, QSCALE};
            pg8::gemm_phase<1>(F.lds, (const char*)(ws + WS_HB), D, S, E, tok, OPAQUE_S(F.wave));
        } SEAM(pb + 0);
        if (IN(pb + 1)) { ph_conv(F, layer); ph_attn(F, layer); } SEAM(pb + 1);
        if (IN(pb + 2)) {
            CArgs a = OPAQUE_ARGS(); unsigned char* const ws = (unsigned char*)(GAS unsigned char*)a->ws;
            pg8::DenseSched S; S.o.init(M / 256, D / 256, F.G, OPAQUE_S(c)); S.Bt = (const char*)(ws + WS_WOUT) + (size_t)layer * D * D * 2; S.tstepB = (size_t)256 * D * 2;
            pg8::EpiResid E{(float*)(ws + WS_H32), AIN(12) + layer * D, ALPHA};
            pg8::gemm_phase<2>(F.lds, (const char*)(ws + WS_MIX), D, S, E, tok, OPAQUE_S(F.wave));
        } SEAM(pb + 2);
        if (IN(pb + 3)) { ph_ln1(F, layer); if (layer == 2) { __syncthreads(); PHASE_PREAMBLE(); cvt_moe_weights(F, a, ws, lane, wave, vcu, 1); } } SEAM(pb + 3);
        if (IN(pb + 4)) {
            {   CArgs a = OPAQUE_ARGS(); unsigned char* const ws = (unsigned char*)(GAS unsigned char*)a->ws;
                pg8::DenseSched S; S.o.init(M / 256, D / 256, F.G, OPAQUE_S(c)); S.Bt = (const char*)(ws + WS_WP) + (size_t)layer * D * DPLE * 2; S.tstepB = (size_t)256 * DPLE * 2;
                pg8::EpiPE E{(bf16_t*)(ws + WS_PE)};
                pg8::gemm_phase<3>(F.lds, (const char*)(ws + WS_PBL), DPLE, S, E, tok, OPAQUE_S(F.wave)); }
            {   CArgs a = OPAQUE_ARGS(); unsigned char* const ws = (unsigned char*)(GAS unsigned char*)a->ws;
                pg8::DenseSched S; S.o.init(M / 256, D / 256, F.G, OPAQUE_S(c)); S.Bt = (const char*)(ws + WS_WG) + (size_t)layer * D * D * 2; S.tstepB = (size_t)256 * D * 2;
                pg8::EpiGate E{(float*)(ws + WS_H32), (const bf16_t*)(ws + WS_PE), AIN(24) + layer * D, ALPHA};
                pg8::gemm_phase<4>(F.lds, (const char*)(ws + WS_HB), D, S, E, tok, OPAQUE_S(F.wave)); }
            if ((layer & 1) == 0) {
                CArgs a = OPAQUE_ARGS(); unsigned char* const ws = (unsigned char*)(GAS unsigned char*)a->ws;
                pg8::DenseSched S; S.o.init(M / 256, 2 * DFF / 256, F.G, OPAQUE_S(c)); S.Bt = (const char*)(ws + WS_W13) + (size_t)jd * 2 * DFF * D * 2; S.tstepB = (size_t)256 * D * 2;
                pg8::EpiSwiglu E{(bf16_t*)(ws + WS_ACT), DFF};
                pg8::gemm_phase<5>(F.lds, (const char*)(ws + WS_HB), D, S, E, tok, OPAQUE_S(F.wave));
            } else {
                PHASE_PREAMBLE();
                MoeTiles T; moe_tiles(ws, jd, T);
                pg8::MoeSched<true> S; S.o.init(T.ts[NE], 2 * DFE / 256, F.G, OPAQUE_S(c)); S.Bt = (const char*)(ws + WS_WM); S.tstepB = (size_t)256 * D * 2; S.estepB = WM13_E;
                S.t1 = T.ts[1]; S.t2 = T.ts[2]; S.t3 = T.ts[3]; S.t4 = T.ts[4]; S.t5 = T.ts[5]; S.t6 = T.ts[6]; S.t7 = T.ts[7];
                {   LAS unsigned short* tw = (LAS unsigned short*)(F.lds + TOK_OFF); const unsigned* list = (const unsigned*)(ws + WS_LIST); pg8::Unit u;
                    for (int i = 0; i < 32 && S.next(i, u); ++i) { const int e = S.expert(u.pm);
                        int ce = 0, te = 0;
#pragma unroll
                        for (int x = 0; x < NE; ++x) if (x == e) { ce = T.cnt[x]; te = T.ts[x]; }
                        if (tid < 256) { const int s = (u.pm - te) * 256 + tid; tw[i * 256 + tid] = (unsigned short)(s < ce ? list[(size_t)e * M + s] : 0u); } }
                    __syncthreads(); }
                pg8::EpiSwiglu E{(bf16_t*)(ws + WS_ACT), DFE};
                pg8::gemm_phase<6>(F.lds, (const char*)(ws + WS_HB), D, S, E, tok, OPAQUE_S(F.wave));
            }
        } SEAM(pb + 4);
        if (IN(pb + 5)) {
            if ((layer & 1) == 0) {
                CArgs a = OPAQUE_ARGS(); unsigned char* const ws = (unsigned char*)(GAS unsigned char*)a->ws;
                pg8::DenseSched S; S.o.init(M / 256, D / 256, F.G, OPAQUE_S(c)); S.Bt = (const char*)(ws + WS_W2) + (size_t)jd * D * DFF * 2; S.tstepB = (size_t)256 * DFF * 2;
                pg8::EpiResid E{(float*)(ws + WS_H32), nullptr, 1.f};
                pg8::gemm_phase<7>(F.lds, (const char*)(ws + WS_ACT), DFF, S, E, tok, OPAQUE_S(F.wave));
            } else {
                CArgs a = OPAQUE_ARGS(); unsigned char* const ws = (unsigned char*)(GAS unsigned char*)a->ws;
                MoeTiles T; moe_tiles(ws, jd, T);
                pg8::MoeSched<false> S; S.o.init(T.ts[NE], D / 256, F.G, OPAQUE_S(c)); S.Bt = (const char*)(ws + WS_WM2); S.tstepB = (size_t)256 * DFE * 2; S.estepB = WM2_E;
                S.t1 = T.ts[1]; S.t2 = T.ts[2]; S.t3 = T.ts[3]; S.t4 = T.ts[4]; S.t5 = T.ts[5]; S.t6 = T.ts[6]; S.t7 = T.ts[7];
                pg8::EpiBf16 E{(bf16_t*)(ws + WS_Y), D};
                pg8::gemm_phase<8>(F.lds, (const char*)(ws + WS_ACT), DFE, S, E, tok, OPAQUE_S(F.wave));
            }
        } SEAM(pb + 5);
        if (IN(pb + 6)) { ph_ln2(F, layer); } SEAM(pb + 6);
    }
#undef IN
#undef SEAM
}

extern "C" void kernel_launch(void* const* d_in, const int* in_sizes, int n_in, void* d_out, int out_size, void* d_ws, size_t ws_size, hipStream_t stream) {
    static int grid = 0;
    if (grid == 0) {
        if (n_in != 27 || out_size != M * D || ws_size < WS_END) { fprintf(stderr, "kernel_launch: unexpected problem (n_in %d, out %d, ws %zu < %zu)\n", n_in, out_size, ws_size, (size_t)WS_END); grid = -1; return; }
        int dev = 0, cus = 0, per_cu = 0;
        if (hipGetDevice(&dev) != hipSuccess || hipDeviceGetAttribute(&cus, hipDeviceAttributeMultiprocessorCount, dev) != hipSuccess) { grid = -1; return; }
        if (hipFuncSetAttribute((const void*)mk_fwd, hipFuncAttributeMaxDynamicSharedMemorySize, LDS_BYTES) != hipSuccess) { fprintf(stderr, "kernel_launch: hipFuncSetAttribute failed\n"); grid = -1; return; }
        if (hipOccupancyMaxActiveBlocksPerMultiprocessor(&per_cu, (const void*)mk_fwd, NWAVES * 64, LDS_BYTES) != hipSuccess || per_cu < 1) fprintf(stderr, "kernel_launch: occupancy query says %d\n", per_cu);
        (void)hipGetLastError();
        if (cus < GRID) { fprintf(stderr, "kernel_launch: %d CUs; built for %d\n", cus, GRID); grid = -1; return; }
        grid = GRID;
    }
    if (grid < 0) return;
    if (hipMemsetAsync((char*)d_ws + WS_CTL, 0, CTL_ZERO_BYTES, stream) != hipSuccess) return;
    Args a{};
    for (int i = 0; i < 27; ++i) a.in[i] = (const float*)d_in[i];
    a.out = (float*)d_out; a.ws = (unsigned char*)d_ws;
#if MK_MULTI
    for (int ph = 0; ph < NPH; ++ph) { a.ph_lo = ph; a.ph_hi = ph + 1; hipLaunchKernelGGL(mk_fwd, dim3(grid), dim3(NWAVES * 64), LDS_BYTES, stream, a); }
#else
    a.ph_lo = 0; a.ph_hi = NPH; hipLaunchKernelGGL(mk_fwd, dim3(grid), dim3(NWAVES * 64), LDS_BYTES, stream, a);
#endif
}
```

```cpp
#include <hip/hip_runtime.h>
#include <cstdio>
#include <cstdint>

#ifndef PROBE_DUP
#define PROBE_DUP 0
#endif
#ifndef MK_MULTI
#define MK_MULTI 0
#endif

#define GAS __attribute__((address_space(1)))
#define LAS __attribute__((address_space(3)))
typedef unsigned short bf16_t;
typedef short bf16x8 __attribute__((ext_vector_type(8)));
typedef float f32x4 __attribute__((ext_vector_type(4)));
typedef float f32x2 __attribute__((ext_vector_type(2)));
typedef unsigned u32x4 __attribute__((ext_vector_type(4)));
typedef unsigned u32x2 __attribute__((ext_vector_type(2)));
typedef GAS unsigned gu32;

constexpr int D = 1024, BATCH = 4, SEQ = 8192, DEPTH = 4, M = BATCH * SEQ;
constexpr int CONV_CH = 512, NH = 8, HD = 64, DIN = 2560, CONV_K = 31, GRID_W = 64, ROWS = SEQ / GRID_W;
constexpr int DFF = 2816, NE = 8, DFE = 3584, DPLE = 256;
constexpr float LN_EPS = 1e-5f;
constexpr float ALPHA = 1.681792830507429f;
constexpr float LOG2E = 1.4426950408889634f;
constexpr float QSCALE = 0.125f * LOG2E;
constexpr int NWAVES = 8;
constexpr int GRID = 256;
constexpr int MAXT = 263;

constexpr size_t MiB = 1u << 20;
constexpr size_t WS_CTL = 0, CTL_ZERO_BYTES = 1 * MiB;
constexpr size_t WS_TOKE = 1 * MiB;
constexpr size_t WS_TOKS = WS_TOKE + 128 * 1024;
constexpr size_t WS_TOKG = WS_TOKS + 256 * 1024;
constexpr size_t WS_LIST = 2 * MiB;
constexpr size_t WS_H32 = 4 * MiB;
constexpr size_t WS_HB = 132 * MiB;
constexpr size_t WS_PE = 196 * MiB;
constexpr size_t WS_Y = WS_PE;
constexpr size_t WS_PBL = 328 * MiB;
constexpr size_t WS_ACT = 344 * MiB;
constexpr size_t WS_AG = WS_ACT;
constexpr size_t WS_Q = WS_AG + 64 * MiB;
constexpr size_t WS_K = WS_Q + 32 * MiB;
constexpr size_t WS_V = WS_K + 32 * MiB;
constexpr size_t WS_MIX = WS_V + 32 * MiB;
constexpr size_t WS_WM = 805 * MiB;
constexpr size_t WM13_E = (size_t)2 * DFE * D * 2, WM2_E = (size_t)D * DFE * 2;
constexpr size_t WS_WM2 = WS_WM + 8 * WM13_E;
constexpr size_t WS_WS = 973 * MiB;
constexpr size_t WS_WIN = WS_WS;
constexpr size_t WS_WOUT = WS_WIN + 4 * (size_t)DIN * D * 2;
constexpr size_t WS_WG = WS_WOUT + 4 * (size_t)D * D * 2;
constexpr size_t WS_WP = WS_WG + 4 * (size_t)D * D * 2;
constexpr size_t WS_W13 = WS_WP + 4 * (size_t)D * DPLE * 2;
constexpr size_t WS_W2 = WS_W13 + 2 * (size_t)2 * DFF * D * 2;
constexpr size_t WS_END = WS_W2 + 2 * (size_t)D * DFF * 2;
static_assert(WS_ACT + (size_t)MAXT * 256 * DFE * 2 <= WS_WM && WS_Y + (size_t)MAXT * 256 * D * 2 <= WS_PBL && WS_MIX + 64 * MiB <= WS_WM && WS_WM2 + 8 * WM2_E <= WS_WS && WS_END <= 1044 * MiB, "d_ws map");
constexpr int CW_TMO = 0, CW_CODE = 1;
constexpr int CW_BAR = 4096;
constexpr int CW_CNT = 8192;

constexpr int RING_BYTES = 131072;
constexpr int TOK_OFF = RING_BYTES;
constexpr int TOK_BYTES = 32 * 512;
constexpr int MISC_OFF = TOK_OFF + TOK_BYTES;
constexpr int LDS_BYTES = MISC_OFF + 256;
static_assert(LDS_BYTES <= 160 * 1024, "LDS");

#define RLX_AGENT __ATOMIC_RELAXED, __HIP_MEMORY_SCOPE_AGENT
#define LDS_WAIT() asm volatile("s_waitcnt lgkmcnt(0)" ::: "memory")
#define VM_WAIT() asm volatile("s_waitcnt vmcnt(0)" ::: "memory")
__device__ __forceinline__ unsigned cvt_pk_bf16(float lo, float hi) { unsigned r; asm volatile("v_cvt_pk_bf16_f32 %0, %1, %2" : "=v"(r) : "v"(lo), "v"(hi)); return r; }
__device__ __forceinline__ float bf_lo(unsigned u) { return __uint_as_float(u << 16); }
__device__ __forceinline__ float bf_hi(unsigned u) { return __uint_as_float(u & 0xffff0000u); }
__device__ __forceinline__ float bf2f(bf16_t u) { return __uint_as_float((unsigned)u << 16); }
template <int X> __device__ __forceinline__ float swz_xor(float v) { return __int_as_float(__builtin_amdgcn_ds_swizzle(__float_as_int(v), (X << 10) | 0x1f)); }
__device__ __forceinline__ float xor32(float v) { auto r = __builtin_amdgcn_permlane32_swap(__float_as_uint(v), __float_as_uint(v), false, false); return __uint_as_float(r[0]) + __uint_as_float(r[1]); }
__device__ __forceinline__ float wave_sum(float v) {
    v += swz_xor<1>(v); v += swz_xor<2>(v); v += swz_xor<4>(v); v += swz_xor<8>(v); v += swz_xor<16>(v);
    return xor32(v);
}
template <int ID> __device__ __forceinline__ int opaque_lane() { int l; asm volatile("; opaque lane %c1\n\tv_mbcnt_lo_u32_b32 %0, -1, 0\n\tv_mbcnt_hi_u32_b32 %0, -1, %0" : "=v"(l) : "i"(ID)); return l; }
#define OPAQUE_LANE() opaque_lane<__COUNTER__>()
template <int ID> __device__ __forceinline__ int opaque_s(int x) { asm volatile("; opaque scalar %c1" : "+s"(x) : "i"(ID)); return x; }
#define OPAQUE_S(x) opaque_s<__COUNTER__>(x)
__device__ __forceinline__ float fast_sigmoid(float x) { return __builtin_amdgcn_rcpf(1.f + __builtin_amdgcn_exp2f(-LOG2E * x)); }

#define XB_TMO      128
#define XB_XCNT(j)  (256  + 64 * (j))
#define XB_XSUB(j)  (1280 + 64 * (j))
#define XB_XGEN(j)  (2304 + 64 * (j))
#define XB_TOP      3328
#define XB_TOPGEN   3392
#define XCD_BAR_WORDS 3456
#define XB_SPIN_CAP (1u << 18)
template <class P> __device__ __forceinline__ unsigned xb_ld(P p)              { return __hip_atomic_load(p, __ATOMIC_RELAXED, __HIP_MEMORY_SCOPE_AGENT); }
template <class P> __device__ __forceinline__ unsigned xb_add(P p, unsigned v) { return __hip_atomic_fetch_add(p, v, __ATOMIC_RELAXED, __HIP_MEMORY_SCOPE_AGENT); }
__device__ __forceinline__ unsigned xb_xcc_id() { return (unsigned)__builtin_amdgcn_s_getreg((3 << 11) | 20) & 0xFu; }
#define XB_SPIN(cond, bar) do { unsigned _sp = 0; while (cond) { __builtin_amdgcn_s_sleep(1); \
    if ((++_sp & 255u) == 0u) { if (xb_ld(&(bar)[XB_TMO])) break; if (_sp > XB_SPIN_CAP) { (void)xb_add(&(bar)[XB_TMO], 1u); break; } } } } while (0)
struct XcdBarrier { unsigned* bar; unsigned x; volatile LAS unsigned* st; };
__device__ __forceinline__ XcdBarrier xcd_barrier_post(unsigned* bar, volatile LAS unsigned* st) {
    XcdBarrier b; b.bar = bar; b.x = xb_xcc_id(); b.st = st;
    if (threadIdx.x == 0) (void)xb_add((GAS unsigned*)&bar[XB_XCNT(b.x)], 1u);
    return b;
}
__device__ __forceinline__ void xcd_barrier_complete(GAS unsigned* bar, unsigned x, unsigned& nloc, unsigned& nx) {
    const unsigned G = GRID;
    unsigned sum, cnt, mine, sp = 0u;
    for (;;) {
        sum = 0u; cnt = 0u; mine = 0u;
#pragma unroll
        for (unsigned j = 0; j < 16; ++j) { const unsigned c = xb_ld(&bar[XB_XCNT(j)]); sum += c; cnt += (c > 0u) ? 1u : 0u; mine = (j == x) ? c : mine; }
        if (sum == G) break;
        __builtin_amdgcn_s_sleep(1);
        if ((++sp & 255u) == 0u) { if (xb_ld(&bar[XB_TMO])) break; if (sp > XB_SPIN_CAP) { (void)xb_add(&bar[XB_TMO], 1u); break; } }
    }
    nloc = mine > 0u ? mine : 1u; nx = cnt > 0u ? cnt : 1u;
}
template <int ID> __device__ __forceinline__ void xcd_barrier(const XcdBarrier& b, const int tid) {
    asm volatile("s_waitcnt vmcnt(0)" ::: "memory");
    __syncthreads();
    if (tid == 0) {
        unsigned* bar0 = b.bar; asm volatile("; opaque bar %c1" : "+s"(bar0) : "i"(ID)); GAS unsigned* bar = (GAS unsigned*)bar0;
        __builtin_amdgcn_s_waitcnt(0);
        unsigned nloc = b.st[0], nx = b.st[1];
        if (nloc == 0u) { xcd_barrier_complete(bar, b.x, nloc, nx); b.st[0] = nloc; b.st[1] = nx; }
        const unsigned old = xb_add(&bar[XB_XSUB(b.x)], 1u);
        const unsigned gen = old / nloc;
        if (old + 1u == (gen + 1u) * nloc) {
            __builtin_amdgcn_fence(__ATOMIC_RELEASE, "agent");
            asm volatile("s_waitcnt vmcnt(0)" ::: "memory");
            const unsigned og = xb_add(&bar[XB_TOP], 1u);
            const unsigned tg = og / nx;
            if (og + 1u == (tg + 1u) * nx) xb_add(&bar[XB_TOPGEN], 1u);
            else XB_SPIN(xb_ld(&bar[XB_TOPGEN]) == tg, bar);
            __builtin_amdgcn_fence(__ATOMIC_ACQUIRE, "agent");
            xb_add(&bar[XB_XGEN(b.x)], 1u);
            asm volatile("s_waitcnt vmcnt(0)" ::: "memory");
        } else {
            XB_SPIN(xb_ld(&bar[XB_XGEN(b.x)]) == gen, bar);
            __builtin_amdgcn_fence(__ATOMIC_ACQUIRE, "agent");
            asm volatile("s_waitcnt vmcnt(0)" ::: "memory");
        }
    }
    __syncthreads();
}

namespace pg8 {
constexpr int BM = 256, BK = 64, HALF = 128, HTB = HALF * BK * 2, STAGE_BYTES = 8 * HTB, NXCD = 8, WGM = 8;
__host__ __device__ __forceinline__ int lds_byte(int r, int c) { const int st = (r >> 4) * 2 + (c >> 5), rr = r & 15, cc = c & 31, ob = rr * 64 + cc * 2; return st * 1024 + (ob ^ (((ob >> 9) & 1) << 5)); }
__host__ __device__ __forceinline__ void stage_rc(int b, int& R, int& C) { const int st = b / 1024, sb = b % 1024, swz = sb ^ (((sb >> 9) & 1) << 5); R = (st >> 1) * 16 + swz / 64; C = (st & 1) * 32 + (swz % 64) / 2; }
__host__ __device__ __forceinline__ int perm32(int rho) { const int n = rho >> 4, i = rho & 15; return 8 * (i >> 2) + 4 * n + (i & 3); }
struct Unit { int pm, pn; };
struct StaticOrder {
    int nM, nN, nwg, c; static constexpr int G = GRID;
    __device__ __forceinline__ void init(int nM_, int nN_, int, int c_) { nM = nM_; nN = nN_; nwg = nM * nN; c = c_; }
    __device__ __forceinline__ bool next(int i, Unit& u) const {
        const long L = (long)i * G + c; if (L >= nwg) return false;
        int wgid = (int)L; { const int q = nwg / NXCD, r = nwg % NXCD, xcd = wgid % NXCD, off = wgid / NXCD; wgid = (xcd < r ? xcd * (q + 1) : r * (q + 1) + (xcd - r) * q) + off; }
        const int nig = WGM * nN, gid = wgid / nig, fm = gid * WGM, gsz = (nM - fm) < WGM ? (nM - fm) : WGM;
        u.pm = fm + ((wgid % nig) % gsz); u.pn = (wgid % nig) / gsz; return true;
    }
};
struct DenseSched {
    static constexpr bool GATHER = false;
    StaticOrder o; const char* Bt; size_t tstepB;
    __device__ __forceinline__ bool next(int i, Unit& u) const { return o.next(i, u); }
    __device__ __forceinline__ const char* bptr(const Unit& u) const { return Bt + (size_t)u.pn * tstepB; }
};
template <bool GATHER_> struct MoeSched {
    static constexpr bool GATHER = GATHER_;
    StaticOrder o; const char* Bt; size_t tstepB, estepB; int t1, t2, t3, t4, t5, t6, t7;
    __device__ __forceinline__ bool next(int i, Unit& u) const { return o.next(i, u); }
    __device__ __forceinline__ int expert(int pm) const { return (pm >= t1) + (pm >= t2) + (pm >= t3) + (pm >= t4) + (pm >= t5) + (pm >= t6) + (pm >= t7); }
    __device__ __forceinline__ const char* bptr(const Unit& u) const { return Bt + (size_t)expert(u.pm) * estepB + (size_t)u.pn * tstepB; }
};

typedef f32x4 Acc[2][2][4][2];
struct EpiProj {
    static constexpr bool PERM = true;
    bf16_t *AG, *Q, *Kb, *V; const float* bias; float qscale;
    __device__ __forceinline__ void operator()(const Acc& acc, const Unit& u, int wr, int wc, int fr, int fq) const {
        const int pn = u.pn; bf16_t* base; int ldc, colt; float sc = 1.f;
        if (pn < 4) { base = AG; ldc = 1024; colt = pn * 256; }
        else if (pn < 6) { base = Q; ldc = 512; colt = (pn - 4) * 256; sc = qscale; }
        else if (pn < 8) { base = Kb; ldc = 512; colt = (pn - 6) * 256; }
        else { base = V; ldc = 512; colt = (pn - 8) * 256; }
        const int row0 = u.pm * BM + wr * 64 + fr, col0 = colt + wc * 32 + 8 * fq, bcol0 = pn * BM + wc * 32 + 8 * fq;
        f32x4 bv[2][2];
#pragma unroll
        for (int bj = 0; bj < 2; ++bj)
#pragma unroll
            for (int n = 0; n < 2; ++n) bv[bj][n] = *(const f32x4*)(bias + bcol0 + bj * HALF + 4 * n);
#pragma unroll
        for (int ai = 0; ai < 2; ++ai)
#pragma unroll
            for (int m = 0; m < 4; ++m) { bf16_t* rowp = base + (size_t)(row0 + ai * HALF + m * 16) * ldc + col0;
#pragma unroll
                for (int bj = 0; bj < 2; ++bj) { const f32x4 v0 = (acc[ai][bj][m][0] + bv[bj][0]) * sc, v1 = (acc[ai][bj][m][1] + bv[bj][1]) * sc;
                    u32x4 w; w.x = cvt_pk_bf16(v0[0], v0[1]); w.y = cvt_pk_bf16(v0[2], v0[3]); w.z = cvt_pk_bf16(v1[0], v1[1]); w.w = cvt_pk_bf16(v1[2], v1[3]);
                    *(u32x4*)(rowp + bj * HALF) = w; } }
    }
};
struct EpiBf16 {
    static constexpr bool PERM = true;
    bf16_t* O; int ldc;
    __device__ __forceinline__ void operator()(const Acc& acc, const Unit& u, int wr, int wc, int fr, int fq) const {
        const int row0 = u.pm * BM + wr * 64 + fr, col0 = u.pn * BM + wc * 32 + 8 * fq;
#pragma unroll
        for (int ai = 0; ai < 2; ++ai)
#pragma unroll
            for (int m = 0; m < 4; ++m) { bf16_t* rowp = O + (size_t)(row0 + ai * HALF + m * 16) * ldc + col0;
#pragma unroll
                for (int bj = 0; bj < 2; ++bj) { const f32x4 v0 = acc[ai][bj][m][0], v1 = acc[ai][bj][m][1];
                    u32x4 w; w.x = cvt_pk_bf16(v0[0], v0[1]); w.y = cvt_pk_bf16(v0[2], v0[3]); w.z = cvt_pk_bf16(v1[0], v1[1]); w.w = cvt_pk_bf16(v1[2], v1[3]);
                    *(u32x4*)(rowp + bj * HALF) = w; } }
    }
};
struct EpiSwiglu {
    static constexpr bool PERM = true;
    bf16_t* O; int ldc;
    __device__ __forceinline__ void operator()(const Acc& acc, const Unit& u, int wr, int wc, int fr, int fq) const {
        const int row0 = u.pm * BM + wr * 64 + fr, col0 = u.pn * HALF + wc * 32 + 8 * fq;
#pragma unroll
        for (int ai = 0; ai < 2; ++ai)
#pragma unroll
            for (int m = 0; m < 4; ++m) { bf16_t* rowp = O + (size_t)(row0 + ai * HALF + m * 16) * ldc + col0;
                f32x4 r[2];
#pragma unroll
                for (int n = 0; n < 2; ++n) { const f32x4 g = acc[ai][0][m][n], up = acc[ai][1][m][n];
#pragma unroll
                    for (int j = 0; j < 4; ++j) r[n][j] = g[j] * fast_sigmoid(g[j]) * up[j]; }
                u32x4 w; w.x = cvt_pk_bf16(r[0][0], r[0][1]); w.y = cvt_pk_bf16(r[0][2], r[0][3]); w.z = cvt_pk_bf16(r[1][0], r[1][1]); w.w = cvt_pk_bf16(r[1][2], r[1][3]);
                *(u32x4*)rowp = w; }
    }
};
struct EpiResid {
    static constexpr bool PERM = false;
    float* H; const bf16_t* HB; const float* bias; float alpha;
    __device__ __forceinline__ void operator()(const Acc& acc, const Unit& u, int wr, int wc, int fr, int fq) const {
        const int row0 = u.pm * BM + wr * 64 + fr, col0 = u.pn * BM + wc * 32 + 4 * fq;
        f32x4 bv[2][2];
#pragma unroll
        for (int bj = 0; bj < 2; ++bj)
#pragma unroll
            for (int n = 0; n < 2; ++n) bv[bj][n] = bias ? *(const f32x4*)(bias + col0 + bj * HALF + n * 16) : (f32x4){0.f, 0.f, 0.f, 0.f};
#pragma unroll
        for (int ai = 0; ai < 2; ++ai)
#pragma unroll
            for (int m = 0; m < 4; ++m) { const size_t off = (size_t)(row0 + ai * HALF + m * 16) * D + col0;
#pragma unroll
                for (int bj = 0; bj < 2; ++bj)
#pragma unroll
                    for (int n = 0; n < 2; ++n) { f32x4* p = (f32x4*)(H + off + bj * HALF + n * 16); f32x4 h;
                        if (HB) { const u32x2 hb = *(const u32x2*)(HB + off + bj * HALF + n * 16); h = (f32x4){bf_lo(hb.x), bf_hi(hb.x), bf_lo(hb.y), bf_hi(hb.y)} * alpha; } else h = *p;
                        *p = h + acc[ai][bj][m][n] + bv[bj][n]; }
                if (m & 1) asm volatile("" ::: "memory"); }
    }
};
struct EpiPE {
    static constexpr bool PERM = false;
    bf16_t* O;
    __device__ __forceinline__ void operator()(const Acc& acc, const Unit& u, int wr, int wc, int fr, int fq) const {
        const int row0 = u.pm * BM + wr * 64 + fr, col0 = u.pn * BM + wc * 32 + 4 * fq;
#pragma unroll
        for (int ai = 0; ai < 2; ++ai)
#pragma unroll
            for (int m = 0; m < 4; ++m) { bf16_t* rowp = O + (size_t)(row0 + ai * HALF + m * 16) * D + col0;
#pragma unroll
                for (int bj = 0; bj < 2; ++bj)
#pragma unroll
                    for (int n = 0; n < 2; ++n) { const f32x4 v = acc[ai][bj][m][n]; u32x2 w; w.x = cvt_pk_bf16(v[0], v[1]); w.y = cvt_pk_bf16(v[2], v[3]); *(u32x2*)(rowp + bj * HALF + n * 16) = w; } }
    }
};
struct EpiGate {
    static constexpr bool PERM = false;
    float* H; const bf16_t* HB; const bf16_t* PE; const float* bias; float alpha;
    __device__ __forceinline__ void operator()(const Acc& acc, const Unit& u, int wr, int wc, int fr, int fq) const {
        const int row0 = u.pm * BM + wr * 64 + fr, col0 = u.pn * BM + wc * 32 + 4 * fq;
        f32x4 bv[2][2];
#pragma unroll
        for (int bj = 0; bj < 2; ++bj)
#pragma unroll
            for (int n = 0; n < 2; ++n) bv[bj][n] = *(const f32x4*)(bias + col0 + bj * HALF + n * 16);
#pragma unroll
        for (int ai = 0; ai < 2; ++ai)
#pragma unroll
            for (int m = 0; m < 4; ++m) { const size_t off = (size_t)(row0 + ai * HALF + m * 16) * D + col0;
#pragma unroll
                for (int bj = 0; bj < 2; ++bj)
#pragma unroll
                    for (int n = 0; n < 2; ++n) { f32x4* p = (f32x4*)(H + off + bj * HALF + n * 16); const u32x2 hb = *(const u32x2*)(HB + off + bj * HALF + n * 16); const f32x4 h = (f32x4){bf_lo(hb.x), bf_hi(hb.x), bf_lo(hb.y), bf_hi(hb.y)}; const u32x2 pe = *(const u32x2*)(PE + off + bj * HALF + n * 16);
                        const f32x4 a = acc[ai][bj][m][n] + bv[bj][n]; f32x4 o;
                        o[0] = h[0] * alpha + fast_sigmoid(a[0]) * bf_lo(pe.x); o[1] = h[1] * alpha + fast_sigmoid(a[1]) * bf_hi(pe.x);
                        o[2] = h[2] * alpha + fast_sigmoid(a[2]) * bf_lo(pe.y); o[3] = h[3] * alpha + fast_sigmoid(a[3]) * bf_hi(pe.y); *p = o; }
                if (m & 1) asm volatile("" ::: "memory"); }
    }
};

template <int SITE, class Epi, class Sched>
__device__ __forceinline__ void gemm_phase(LAS unsigned char* lds, const char* Abase, const int K, const Sched& S, const Epi& E, const LAS unsigned short* tok, const int wid) {
    const int lane = opaque_lane<1000 + 2 * SITE>();
    const int tid = wid * 64 + lane, wr = wid >> 2, wc = wid & 3, fr = lane & 15, fq = lane >> 4;
    const int nt = K / BK;
    unsigned voffB[2], vC[2][2], vN[2][2]; int Rr[2], Cc[2];
#pragma unroll
    for (int i = 0; i < 2; ++i) { int R, C; stage_rc(tid * 16 + i * 8192, R, C); const int Rb = Epi::PERM ? ((R & ~31) + perm32(R & 31)) : R;
        voffB[i] = (unsigned)(Rb * K + C) * 2u; Rr[i] = R; Cc[i] = C;
        vC[0][i] = (unsigned)(R * K + C) * 2u; vC[1][i] = vC[0][i]; vN[0][i] = vC[0][i]; vN[1][i] = vC[0][i]; }
    const size_t kstep = (size_t)(BK * 2);
    const size_t hstep = (size_t)HALF * K * 2;
    const size_t tstep = 2 * hstep;
    const size_t ah = Sched::GATHER ? 0 : hstep;
    const unsigned ldsw = (unsigned)wid * 1024u;
    const int aoff = lds_byte(wr * 64 + fr, fq * 8), boff = lds_byte(wc * 32 + fr, fq * 8);
#define PG8_SA(b, h) (((b) * 2 + (h)) * HTB)
#define PG8_SB(b, h) ((4 + (b) * 2 + (h)) * HTB)
#define PG8_STAGE(bufoff, gbase, voff) do { _Pragma("unroll") for (int _i = 0; _i < 2; ++_i) \
        __builtin_amdgcn_global_load_lds((const unsigned*)((const char*)(gbase) + (voff)[_i]), (LAS unsigned*)(lds + (bufoff) + ldsw + _i * 8192), 16, 0, 0); } while (0)
#define PG8_LDA(dst, b, h) do { _Pragma("unroll") for (int m = 0; m < 4; ++m) _Pragma("unroll") for (int k = 0; k < 2; ++k) dst[m][k] = *(const LAS bf16x8*)(lds + PG8_SA(b, h) + aoff + m * 2048 + k * 1024); } while (0)
#define PG8_LDB(dst, b, h) do { _Pragma("unroll") for (int n = 0; n < 2; ++n) _Pragma("unroll") for (int k = 0; k < 2; ++k) dst[n][k] = *(const LAS bf16x8*)(lds + PG8_SB(b, h) + boff + n * 2048 + k * 1024); } while (0)
#define PG8_MMA(ai, bj, At, Bt) do { __builtin_amdgcn_s_setprio(1); _Pragma("unroll") for (int m = 0; m < 4; ++m) _Pragma("unroll") for (int n = 0; n < 2; ++n) _Pragma("unroll") for (int k = 0; k < 2; ++k) \
        acc[ai][bj][m][n] = __builtin_amdgcn_mfma_f32_16x16x32_bf16(Bt[n][k], At[m][k], acc[ai][bj][m][n], 0, 0, 0); __builtin_amdgcn_s_setprio(0); } while (0)
#define PG8_WAIT_V(n) asm volatile("s_waitcnt vmcnt(" #n ")" ::: "memory")
#define PG8_WAIT_L(n) asm volatile("s_waitcnt lgkmcnt(" #n ")" ::: "memory")
#define PG8_BAR __builtin_amdgcn_s_barrier()
#define PG8_SCHED __builtin_amdgcn_sched_barrier(0)
#define PG8_GATHER(dst, unit_i) do { _Pragma("unroll") for (int _h = 0; _h < 2; ++_h) _Pragma("unroll") for (int _i = 0; _i < 2; ++_i) \
        dst[_h][_i] = (unsigned)tok[(unit_i) * 256 + _h * HALF + Rr[_i]] * (unsigned)(K * 2) + (unsigned)(Cc[_i] * 2); } while (0)
    Unit cur, nxt; int ui = 0;
    if (!S.next(0, cur)) return;
    Acc acc;
#pragma unroll
    for (int a = 0; a < 2; ++a)
#pragma unroll
        for (int b = 0; b < 2; ++b)
#pragma unroll
            for (int m = 0; m < 4; ++m)
#pragma unroll
                for (int n = 0; n < 2; ++n) acc[a][b][m][n] = (f32x4){0.f, 0.f, 0.f, 0.f};
    bf16x8 At[4][2], B0[2][2], B1[2][2];
    if constexpr (Sched::GATHER) { PG8_GATHER(vC, 0); }
    const char* cA = Sched::GATHER ? Abase : Abase + (size_t)cur.pm * tstep; const char* cB = S.bptr(cur);
    PG8_STAGE(PG8_SB(0, 0), cB, voffB); PG8_STAGE(PG8_SB(0, 1), cB + hstep, voffB); PG8_STAGE(PG8_SA(0, 0), cA, vC[0]); PG8_STAGE(PG8_SA(0, 1), cA + ah, vC[1]);
    if (wr == 1) PG8_BAR;
    PG8_WAIT_V(2); PG8_BAR;
    PG8_STAGE(PG8_SB(1, 0), cB + kstep, voffB); PG8_STAGE(PG8_SA(1, 0), cA + kstep, vC[0]); PG8_STAGE(PG8_SB(1, 1), cB + hstep + kstep, voffB);
    PG8_WAIT_V(6); PG8_BAR;
    for (;;) {
        const bool has_next = S.next(ui + 1, nxt);
        const char* nA = (has_next && !Sched::GATHER) ? Abase + (size_t)nxt.pm * tstep : cA; const char* nB = has_next ? S.bptr(nxt) : cB;
        if constexpr (Sched::GATHER) { if (has_next) { PG8_GATHER(vN, ui + 1); } else { vN[0][0] = vC[0][0]; vN[0][1] = vC[0][1]; vN[1][0] = vC[1][0]; vN[1][1] = vC[1][1]; } }
        for (int t = 0; t < nt; t += 2) {
            const bool last = (t == nt - 2);
            const char* a1 = cA + (size_t)(t + 1) * kstep;
            const char* a2 = last ? nA : cA + (size_t)(t + 2) * kstep; const char* b2 = last ? nB : cB + (size_t)(t + 2) * kstep;
            const char* a3 = a2 + kstep; const char* b3 = b2 + kstep;
            unsigned vX[2][2];
            if constexpr (Sched::GATHER) { vX[0][0] = last ? vN[0][0] : vC[0][0]; vX[0][1] = last ? vN[0][1] : vC[0][1]; vX[1][0] = last ? vN[1][0] : vC[1][0]; vX[1][1] = last ? vN[1][1] : vC[1][1]; }
            else { vX[0][0] = vC[0][0]; vX[0][1] = vC[0][1]; vX[1][0] = vC[1][0]; vX[1][1] = vC[1][1]; }
            PG8_LDB(B0, 0, 0); PG8_LDB(B1, 0, 1); PG8_SCHED; PG8_LDA(At, 0, 0); PG8_STAGE(PG8_SA(1, 1), a1 + ah, vC[1]);
            PG8_WAIT_V(8); PG8_WAIT_L(0); PG8_BAR; PG8_MMA(0, 0, At, B0); PG8_MMA(0, 1, At, B1); PG8_BAR; PG8_SCHED;
            PG8_LDA(At, 0, 1); PG8_STAGE(PG8_SB(0, 0), b2, voffB); PG8_STAGE(PG8_SB(0, 1), b2 + hstep, voffB); PG8_STAGE(PG8_SA(0, 0), a2, vX[0]);
            PG8_WAIT_V(8); PG8_WAIT_L(0); PG8_BAR; PG8_MMA(1, 0, At, B0); PG8_MMA(1, 1, At, B1); PG8_BAR; PG8_SCHED;
            PG8_LDB(B0, 1, 0); PG8_LDB(B1, 1, 1); PG8_SCHED; PG8_LDA(At, 1, 0); PG8_STAGE(PG8_SA(0, 1), a2 + ah, vX[1]);
            PG8_WAIT_V(8); PG8_WAIT_L(0); PG8_BAR; PG8_MMA(0, 0, At, B0); PG8_MMA(0, 1, At, B1); PG8_BAR; PG8_SCHED;
            PG8_LDA(At, 1, 1); PG8_STAGE(PG8_SB(1, 0), b3, voffB); PG8_STAGE(PG8_SB(1, 1), b3 + hstep, voffB); PG8_STAGE(PG8_SA(1, 0), a3, vX[0]);
            PG8_WAIT_V(8); PG8_WAIT_L(0); PG8_BAR; PG8_MMA(1, 0, At, B0); PG8_MMA(1, 1, At, B1); PG8_BAR; PG8_SCHED;
        }
        if (wr == 0) PG8_BAR;
        { const int l2 = opaque_lane<1001 + 2 * SITE>(); E(acc, cur, wr, wc, l2 & 15, l2 >> 4); }
        if (!has_next) break;
#pragma unroll
        for (int a = 0; a < 2; ++a)
#pragma unroll
            for (int b = 0; b < 2; ++b)
#pragma unroll
                for (int m = 0; m < 4; ++m)
#pragma unroll
                    for (int n = 0; n < 2; ++n) acc[a][b][m][n] = (f32x4){0.f, 0.f, 0.f, 0.f};
        cur = nxt; cA = nA; cB = nB; ++ui;
        if constexpr (Sched::GATHER) { vC[0][0] = vN[0][0]; vC[0][1] = vN[0][1]; vC[1][0] = vN[1][0]; vC[1][1] = vN[1][1]; }
        if (wr == 1) PG8_BAR;
    }
    PG8_WAIT_V(0);
    PG8_BAR;
#undef PG8_SA
#undef PG8_SB
#undef PG8_STAGE
#undef PG8_LDA
#undef PG8_LDB
#undef PG8_MMA
#undef PG8_WAIT_V
#undef PG8_WAIT_L
#undef PG8_BAR
#undef PG8_SCHED
#undef PG8_GATHER
}
}

struct Args { const float* in[27]; float* out; unsigned char* ws; int ph_lo, ph_hi; };
typedef const __attribute__((address_space(4))) Args* CArgs;
template <int ID> __device__ __forceinline__ CArgs opaque_args() { CArgs p = (CArgs)__builtin_amdgcn_kernarg_segment_ptr(); asm volatile("; opaque args %c1" : "+s"(p) : "i"(ID)); return p; }
#define OPAQUE_ARGS() opaque_args<__COUNTER__>()
struct Frame { LAS unsigned char* lds; int vcu, wave; static constexpr int G = GRID; };
#define AIN(i) ((const float*)(const GAS float*)a->in[i])
#define PHASE_PREAMBLE() CArgs a = OPAQUE_ARGS(); unsigned char* const ws = (unsigned char*)(GAS unsigned char*)a->ws; const int lane = OPAQUE_LANE(), wave = OPAQUE_S(F.wave), vcu = OPAQUE_S(F.vcu), tid = wave * 64 + lane; (void)ws; (void)tid; (void)vcu
constexpr int NPH = 1 + DEPTH * 7;

__device__ __forceinline__ void tr_item(const float* W, int N, bf16_t* WT, int ldt, int k0, int n0, int orow0, LAS float* scr, int lane) {
#pragma unroll 8
    for (int i = 0; i < 32; ++i) { const int kk = 2 * i + (lane >> 5); scr[kk * 33 + (lane & 31)] = W[(size_t)(k0 + kk) * N + n0 + (lane & 31)]; }
    LDS_WAIT(); asm volatile("" ::: "memory");
    const int c = lane & 7;
#pragma unroll
    for (int j = 0; j < 4; ++j) { const int n = (lane >> 3) + 8 * j; const LAS float* s = scr + (8 * c) * 33 + n;
        u32x4 o; o.x = cvt_pk_bf16(s[0 * 33], s[1 * 33]); o.y = cvt_pk_bf16(s[2 * 33], s[3 * 33]); o.z = cvt_pk_bf16(s[4 * 33], s[5 * 33]); o.w = cvt_pk_bf16(s[6 * 33], s[7 * 33]);
        *(u32x4*)(WT + (size_t)(orow0 + n) * ldt + k0 + 8 * c) = o; }
    LDS_WAIT(); asm volatile("" ::: "memory");
}
__device__ __forceinline__ void cvt_class_item(const float* W0, int K, int N, bf16_t* WT0, size_t wt_stride  , int il, int r, LAS float* scr, int lane) {
    const int nblk = N / 32, per = (K / 64) * nblk, mat = r / per, it = r % per, kb = it / nblk, nb = it % nblk, n0 = 32 * nb;
    const int orow0 = il == 0 ? n0 : ((n0 >> 7) * 256 + (n0 & 127) + (il == 2 ? 128 : 0));
    tr_item(W0 + (size_t)mat * K * N, N, WT0 + (size_t)mat * wt_stride, K, 64 * kb, n0, orow0, scr, lane);
}
__device__ __forceinline__ void cvt_static_weights(const Frame& F, CArgs a, unsigned char* ws, int lane, int wave, int vcu) {
    LAS float* scr = (LAS float*)(F.lds + wave * 16384);
    const int gw = vcu * NWAVES + wave, NGW = F.G * NWAVES;
    constexpr int I_IN = 4 * (D / 64) * (DIN / 32), I_OUT = 4 * (D / 64) * (D / 32), I_G = I_OUT, I_P = 4 * (DPLE / 64) * (D / 32), I_F1 = 2 * (D / 64) * (DFF / 32), I_F2 = 2 * (DFF / 64) * (D / 32);
    constexpr int NIT = I_IN + I_OUT + I_G + I_P + 2 * I_F1 + I_F2;
    for (int it = gw; it < NIT; it += NGW) {
        int r = it;
        if (r < I_IN) { cvt_class_item(AIN(4), D, DIN, (bf16_t*)(ws + WS_WIN), (size_t)DIN * D, 0, r, scr, lane); continue; } r -= I_IN;
        if (r < I_OUT) { cvt_class_item(AIN(11), D, D, (bf16_t*)(ws + WS_WOUT), (size_t)D * D, 0, r, scr, lane); continue; } r -= I_OUT;
        if (r < I_G) { cvt_class_item(AIN(23), D, D, (bf16_t*)(ws + WS_WG), (size_t)D * D, 0, r, scr, lane); continue; } r -= I_G;
        if (r < I_P) { cvt_class_item(AIN(22), DPLE, D, (bf16_t*)(ws + WS_WP), (size_t)D * DPLE, 0, r, scr, lane); continue; } r -= I_P;
        if (r < I_F1) { cvt_class_item(AIN(15), D, DFF, (bf16_t*)(ws + WS_W13), (size_t)2 * DFF * D, 1, r, scr, lane); continue; } r -= I_F1;
        if (r < I_F1) { cvt_class_item(AIN(16), D, DFF, (bf16_t*)(ws + WS_W13), (size_t)2 * DFF * D, 2, r, scr, lane); continue; } r -= I_F1;
        cvt_class_item(AIN(17), DFF, D, (bf16_t*)(ws + WS_W2), (size_t)D * DFF, 0, r, scr, lane);
    }
}
__device__ __forceinline__ void cvt_moe_weights(const Frame& F, CArgs a, unsigned char* ws, int lane, int wave, int vcu, int j) {
    LAS float* scr = (LAS float*)(F.lds + wave * 16384);
    const int gw = vcu * NWAVES + wave, NGW = F.G * NWAVES;
    constexpr int I_1 = NE * (D / 64) * (DFE / 32), I_2 = NE * (DFE / 64) * (D / 32);
    const size_t wo = (size_t)j * NE * D * DFE;
    for (int it = gw; it < 2 * I_1 + I_2; it += NGW) {
        int r = it;
        if (r < I_1) { cvt_class_item(AIN(19) + wo, D, DFE, (bf16_t*)(ws + WS_WM), WM13_E / 2, 1, r, scr, lane); continue; } r -= I_1;
        if (r < I_1) { cvt_class_item(AIN(20) + wo, D, DFE, (bf16_t*)(ws + WS_WM), WM13_E / 2, 2, r, scr, lane); continue; } r -= I_1;
        cvt_class_item(AIN(21) + wo, DFE, D, (bf16_t*)(ws + WS_WM2), WM2_E / 2, 0, r, scr, lane);
    }
}

__device__ __forceinline__ void ln_row(f32x4 (&v)[4], const f32x4 (&g)[4], const f32x4 (&b)[4]) {
    float s = 0.f;
#pragma unroll
    for (int j = 0; j < 4; ++j) s += (v[j][0] + v[j][1]) + (v[j][2] + v[j][3]);
    const float mean = wave_sum(s) * (1.f / D); float q = 0.f;
#pragma unroll
    for (int j = 0; j < 4; ++j) { v[j] = v[j] - mean; q += (v[j][0] * v[j][0] + v[j][1] * v[j][1]) + (v[j][2] * v[j][2] + v[j][3] * v[j][3]); }
    const float rstd = 1.f / sqrtf(wave_sum(q) * (1.f / D) + LN_EPS);
#pragma unroll
    for (int j = 0; j < 4; ++j) v[j] = v[j] * rstd * g[j] + b[j];
}
__device__ __forceinline__ void store_row(const f32x4 (&v)[4], float* h32row, bf16_t* hbrow, int lane) {
#pragma unroll
    for (int j = 0; j < 4; ++j) {
        if (h32row) *(f32x4*)(h32row + 4 * lane + 256 * j) = v[j];
        if (hbrow) { u32x2 w; w.x = cvt_pk_bf16(v[j][0], v[j][1]); w.y = cvt_pk_bf16(v[j][2], v[j][3]); *(u32x2*)(hbrow + 4 * lane + 256 * j) = w; }
    }
}

__device__ __forceinline__ void ph_prologue(const Frame& F) {
    PHASE_PREAMBLE();
    cvt_static_weights(F, a, ws, lane, wave, vcu);
    cvt_moe_weights(F, a, ws, lane, wave, vcu, 0);
    const int gw = vcu * NWAVES + wave, NGW = F.G * NWAVES;
    f32x4 g[4], b[4];
#pragma unroll
    for (int j = 0; j < 4; ++j) { g[j] = *(const f32x4*)(AIN(2) + 4 * lane + 256 * j); b[j] = *(const f32x4*)(AIN(3) + 4 * lane + 256 * j); }
    float* H32 = (float*)(ws + WS_H32); bf16_t* HB = (bf16_t*)(ws + WS_HB);
    for (int m = gw; m < M; m += NGW) {
        f32x4 v[4];
#pragma unroll
        for (int j = 0; j < 4; ++j) v[j] = *(const f32x4*)(AIN(0) + (size_t)m * D + 4 * lane + 256 * j);
        ln_row(v, g, b);
        store_row(v, nullptr, HB + (size_t)m * D, lane);
    }
}

__device__ __forceinline__ void ph_conv(const Frame& F, int layer) {
    PHASE_PREAMBLE();
    const bf16_t* AG = (const bf16_t*)(ws + WS_AG); bf16_t* MIX = (bf16_t*)(ws + WS_MIX);
    LAS float* U = (LAS float*)F.lds;
    const int c = tid;
    const float* cw = AIN(6) + (size_t)layer * CONV_K * CONV_CH; const float cb = AIN(7)[layer * CONV_CH + c];
    float w[CONV_K];
#pragma unroll
    for (int k = 0; k < CONV_K; ++k) w[k] = cw[k * CONV_CH + c];
    const float* lg = AIN(8) + layer * CONV_CH; const float* lb = AIN(9) + layer * CONV_CH;
    for (int unit = vcu; unit < M / 32; unit += F.G) {
        const int t0 = unit * 32, bt = t0 / SEQ, tt0 = t0 % SEQ;
        {   const int rq = tid >> 7, c4 = (tid & 127) * 4;
            u32x2 av[16], gv[16];
#pragma unroll
            for (int ps = 0; ps < 16; ++ps) { const int r = ps * 4 + rq, ts = tt0 + r - 15; const bool ok = r < 62 && ts >= 0 && ts < SEQ;
                const bf16_t* p = AG + ((size_t)bt * SEQ + (ok ? ts : tt0)) * 1024 + c4; av[ps] = *(const u32x2*)p; gv[ps] = *(const u32x2*)(p + CONV_CH);
                if (!ok) { av[ps] = (u32x2){0u, 0u}; } }
#pragma unroll
            for (int ps = 0; ps < 16; ++ps) { const int r = ps * 4 + rq;
                f32x4 u; u[0] = bf_lo(av[ps].x) * fast_sigmoid(bf_lo(gv[ps].x)); u[1] = bf_hi(av[ps].x) * fast_sigmoid(bf_hi(gv[ps].x));
                u[2] = bf_lo(av[ps].y) * fast_sigmoid(bf_lo(gv[ps].y)); u[3] = bf_hi(av[ps].y) * fast_sigmoid(bf_hi(gv[ps].y));
                if (r < 62) *(LAS f32x4*)(U + r * CONV_CH + c4) = u; } }
        __syncthreads();
        float y[32];
#pragma unroll
        for (int t = 0; t < 32; ++t) y[t] = cb;
#pragma unroll
        for (int r = 0; r < 62; ++r) { const float x = U[r * CONV_CH + c];
#pragma unroll
            for (int t = 0; t < 32; ++t) if (r - t >= 0 && r - t < CONV_K) y[t] += w[r - t] * x; }
        __syncthreads();
#pragma unroll
        for (int t = 0; t < 32; ++t) U[t * CONV_CH + c] = y[t];
        __syncthreads();
#pragma unroll
        for (int i = 0; i < 4; ++i) { const int t = wave * 4 + i; float v[8]; float s = 0.f;
#pragma unroll
            for (int j = 0; j < 8; ++j) { v[j] = U[t * CONV_CH + lane + 64 * j]; s += v[j]; }
            const float mean = wave_sum(s) * (1.f / CONV_CH); float q = 0.f;
#pragma unroll
            for (int j = 0; j < 8; ++j) { v[j] -= mean; q += v[j] * v[j]; }
            const float rstd = 1.f / sqrtf(wave_sum(q) * (1.f / CONV_CH) + LN_EPS);
#pragma unroll
            for (int j = 0; j < 8; ++j) { float o = v[j] * rstd * lg[lane + 64 * j] + lb[lane + 64 * j]; o = o * fast_sigmoid(o);
                MIX[(size_t)(t0 + t) * 1024 + lane + 64 * j] = (bf16_t)(cvt_pk_bf16(o, 0.f) & 0xffffu); } }
        __syncthreads();
    }
}
__device__ __forceinline__ void ph_attn_simple(const Frame& F, int layer) {
    PHASE_PREAMBLE();
    const bf16_t* Q = (const bf16_t*)(ws + WS_Q); const bf16_t* Kb = (const bf16_t*)(ws + WS_K); const bf16_t* V = (const bf16_t*)(ws + WS_V); bf16_t* MIX = (bf16_t*)(ws + WS_MIX);
    const float* rpb = AIN(10) + (size_t)layer * NH * 15 * 31;
    const int gw = vcu * NWAVES + wave, NGW = F.G * NWAVES;
    for (int w = gw; w < M * NH; w += NGW) {
        const int t = w / NH, h = w % NH;
        const int bt = t / SEQ, tt = t % SEQ, r = tt / GRID_W, c = tt % GRID_W;
        int r0 = r - 4; r0 = r0 < 0 ? 0 : (r0 > ROWS - 8 ? ROWS - 8 : r0);
        int c0 = c - 8; c0 = c0 < 0 ? 0 : (c0 > GRID_W - 16 ? GRID_W - 16 : c0);
        const float q = bf2f(Q[(size_t)t * 512 + h * HD + lane]);
        float mx = -INFINITY, l = 0.f, acc = 0.f;
        for (int i = 0; i < 8; ++i)
            for (int j = 0; j < 16; ++j) {
                const int kr = r0 + i, kc = c0 + j; const size_t kt = (size_t)bt * SEQ + kr * GRID_W + kc;
                const float kv = bf2f(Kb[kt * 512 + h * HD + lane]), vv = bf2f(V[kt * 512 + h * HD + lane]);
                const float s = wave_sum(q * kv) + LOG2E * rpb[(h * 15 + (kr - r + 7)) * 31 + (kc - c + 15)];
                const float nm = fmaxf(mx, s), f = __builtin_amdgcn_exp2f(mx - nm), p = __builtin_amdgcn_exp2f(s - nm);
                l = l * f + p; acc = acc * f + p * vv; mx = nm;
            }
        MIX[(size_t)t * 1024 + CONV_CH + h * HD + lane] = (bf16_t)(cvt_pk_bf16(acc / l, 0.f) & 0xffffu);
    }
}

typedef short v4i16_t __attribute__((ext_vector_type(4)));
constexpr int ATT_TAB_FLOATS = NH * 15 * 32, ATT_VROW = 160, ATT_VBUF = 32 * ATT_VROW;
__device__ __forceinline__ void ph_attn(const Frame& F, int layer) {
    PHASE_PREAMBLE();
    const bf16_t* Q = (const bf16_t*)(ws + WS_Q); const bf16_t* Kb = (const bf16_t*)(ws + WS_K); const bf16_t* V = (const bf16_t*)(ws + WS_V); bf16_t* MIX = (bf16_t*)(ws + WS_MIX);
    LAS float* TAB = (LAS float*)F.lds;
    {   const float* rpb = AIN(10) + (size_t)layer * NH * 15 * 31;
        for (int i = tid; i < ATT_TAB_FLOATS; i += NWAVES * 64) { const int hd = i >> 5, dc = i & 31; TAB[i] = dc < 31 ? LOG2E * rpb[hd * 31 + dc] : -INFINITY; }
        __syncthreads(); }
    LAS unsigned char* vbuf = F.lds + ATT_TAB_FLOATS * 4 + wave * (2 * ATT_VBUF);
    const int fr = lane & 15, fq = lane >> 4, h = wave;
    const int vrd = (4 * fq + ((lane & 15) >> 2)) * ATT_VROW + 8 * (lane & 3);
    for (int u = 0; u < (M / GRID_W) / GRID; ++u) {
        const int br = vcu * ((M / GRID_W) / GRID) + u, b = br / ROWS, r = br % ROWS;
        int r0 = r - 4; r0 = r0 < 0 ? 0 : (r0 > ROWS - 8 ? ROWS - 8 : r0);
        const int drb = r0 - r + 7;
#pragma unroll 1
        for (int j = 0; j < 4; ++j) {
            const int band0 = j == 0 ? 0 : (j == 1 ? 8 : (j == 2 ? 24 : 32));
            const int qc = 16 * j + fr; int win0 = qc - 8; win0 = win0 < 0 ? 0 : (win0 > GRID_W - 16 ? GRID_W - 16 : win0);
            const size_t qtok = (size_t)b * SEQ + r * GRID_W + qc;
            bf16x8 qf[2];
#pragma unroll
            for (int kk = 0; kk < 2; ++kk) qf[kk] = *(const bf16x8*)(Q + qtok * 512 + h * HD + kk * 32 + 8 * fq);
            int tix[2][4];
#pragma unroll
            for (int th = 0; th < 2; ++th)
#pragma unroll
                for (int rg = 0; rg < 4; ++rg) { const int kc = band0 + 16 * th + 4 * fq + rg; const bool ok = kc >= win0 && kc < win0 + 16; tix[th][rg] = (h * 15 + drb) * 32 + (ok ? kc - qc + 15 : 31); }
            const size_t ktok0 = (size_t)b * SEQ + r0 * GRID_W + band0;
            const bf16_t* kp = Kb + (ktok0 + fr) * 512 + h * HD + 8 * fq;
            const bf16_t* vp = V + (ktok0 + (lane >> 3)) * 512 + h * HD + (lane & 7) * 8;
            const int vwr = (lane >> 3) * ATT_VROW + (lane & 7) * 16;
            u32x4 vn[4];
#pragma unroll
            for (int x = 0; x < 4; ++x) vn[x] = *(const u32x4*)(vp + (size_t)(x * 8) * 512);
            f32x4 s[8][2];
#pragma unroll
            for (int i = 0; i < 8; ++i)
#pragma unroll
                for (int th = 0; th < 2; ++th) {
                    const bf16x8 k0 = *(const bf16x8*)(kp + (size_t)(i * GRID_W + th * 16) * 512), k1 = *(const bf16x8*)(kp + (size_t)(i * GRID_W + th * 16) * 512 + 32);
                    f32x4 a = __builtin_amdgcn_mfma_f32_16x16x32_bf16(k0, qf[0], (f32x4){0.f, 0.f, 0.f, 0.f}, 0, 0, 0);
                    s[i][th] = __builtin_amdgcn_mfma_f32_16x16x32_bf16(k1, qf[1], a, 0, 0, 0); }
#pragma unroll
            for (int x = 0; x < 4; ++x) *(LAS u32x4*)(vbuf + vwr + x * 8 * ATT_VROW) = vn[x];
            float mx = -INFINITY;
#pragma unroll
            for (int i = 0; i < 8; ++i)
#pragma unroll
                for (int th = 0; th < 2; ++th)
#pragma unroll
                    for (int rg = 0; rg < 4; ++rg) { s[i][th][rg] += TAB[tix[th][rg] + i * 32]; mx = fmaxf(mx, s[i][th][rg]); }
            mx = fmaxf(mx, swz_xor<16>(mx));
            { auto rr = __builtin_amdgcn_permlane32_swap(__float_as_uint(mx), __float_as_uint(mx), false, false); mx = fmaxf(__uint_as_float(rr[0]), __uint_as_float(rr[1])); }
            float l = 0.f;
#pragma unroll
            for (int i = 0; i < 8; ++i)
#pragma unroll
                for (int th = 0; th < 2; ++th)
#pragma unroll
                    for (int rg = 0; rg < 4; ++rg) { const float pv = __builtin_amdgcn_exp2f(s[i][th][rg] - mx); s[i][th][rg] = pv; l += pv; }
            l += swz_xor<16>(l); l = xor32(l);
            f32x4 o[4];
#pragma unroll
            for (int db = 0; db < 4; ++db) o[db] = (f32x4){0.f, 0.f, 0.f, 0.f};
#pragma unroll
            for (int i = 0; i < 8; ++i) {
                if (i + 1 < 8) {
#pragma unroll
                    for (int x = 0; x < 4; ++x) vn[x] = *(const u32x4*)(vp + (size_t)((i + 1) * GRID_W + x * 8) * 512); }
                u32x4 pw; pw.x = cvt_pk_bf16(s[i][0][0], s[i][0][1]); pw.y = cvt_pk_bf16(s[i][0][2], s[i][0][3]); pw.z = cvt_pk_bf16(s[i][1][0], s[i][1][1]); pw.w = cvt_pk_bf16(s[i][1][2], s[i][1][3]);
                const bf16x8 pf = __builtin_bit_cast(bf16x8, pw);
                LAS unsigned char* vb = vbuf + (i & 1) * ATT_VBUF + vrd;
#pragma unroll
                for (int db = 0; db < 4; ++db) {
                    const v4i16_t t0 = __builtin_amdgcn_ds_read_tr16_b64_v4i16((LAS v4i16_t*)(vb + 32 * db)), t1 = __builtin_amdgcn_ds_read_tr16_b64_v4i16((LAS v4i16_t*)(vb + 16 * ATT_VROW + 32 * db));
                    const bf16x8 vf = (bf16x8){t0[0], t0[1], t0[2], t0[3], t1[0], t1[1], t1[2], t1[3]};
                    o[db] = __builtin_amdgcn_mfma_f32_16x16x32_bf16(vf, pf, o[db], 0, 0, 0); }
                if (i + 1 < 8) {
#pragma unroll
                    for (int x = 0; x < 4; ++x) *(LAS u32x4*)(vbuf + ((i + 1) & 1) * ATT_VBUF + vwr + x * 8 * ATT_VROW) = vn[x]; }
            }
            const float inv = 1.f / l;
            bf16_t* op = MIX + qtok * 1024 + CONV_CH + h * HD + 4 * fq;
#pragma unroll
            for (int db = 0; db < 4; ++db) { u32x2 w; w.x = cvt_pk_bf16(o[db][0] * inv, o[db][1] * inv); w.y = cvt_pk_bf16(o[db][2] * inv, o[db][3] * inv); *(u32x2*)(op + 16 * db) = w; }
        }
    }
    __syncthreads();
}

template <bool DRY = false> __device__ __forceinline__ void ph_ln1(const Frame& F, int layer) {
    PHASE_PREAMBLE();
    const bool moe = !DRY && (layer & 1) != 0; const int jm = layer >> 1;
    float* H32 = (float*)(ws + WS_H32); bf16_t* HB = (bf16_t*)(ws + WS_HB);
    bf16_t* HBo = DRY ? (bf16_t*)(ws + WS_ACT + 128 * MiB) : HB;
    LAS float* WR = (LAS float*)F.lds;
    LAS unsigned* lcnt = (LAS unsigned*)(F.lds + 32768);
    if (moe) {
        const float* wr = AIN(18) + (size_t)jm * D * NE;
        for (int i = tid; i < D * NE / 4; i += NWAVES * 64) ((LAS f32x4*)WR)[i] = ((const f32x4*)wr)[i];
        if (tid < 16) lcnt[tid] = 0u;
        __syncthreads();
    }
    f32x4 g[4], b[4];
#pragma unroll
    for (int j = 0; j < 4; ++j) { g[j] = *(const f32x4*)(AIN(13) + layer * D + 4 * lane + 256 * j); b[j] = *(const f32x4*)(AIN(14) + layer * D + 4 * lane + 256 * j); }
    const int gw = vcu * NWAVES + wave;
    int me0 = 0, me1 = 0; float mg0 = 0.f, mg1 = 0.f;
    for (int i = 0; i < 16; ++i) {
        const int m = gw * 16 + i;
        f32x4 v[4];
#pragma unroll
        for (int j = 0; j < 4; ++j) v[j] = *(const f32x4*)(H32 + (size_t)m * D + 4 * lane + 256 * j);
        ln_row(v, g, b);
        store_row(v, nullptr, HBo + (size_t)m * D, lane);
        if (moe) {
            float lgt[NE];
#pragma unroll
            for (int e = 0; e < NE; ++e) lgt[e] = 0.f;
#pragma unroll
            for (int j = 0; j < 4; ++j)
#pragma unroll
                for (int k = 0; k < 4; ++k) { const int d = 4 * lane + 256 * j + k; const f32x4 w0 = *(const LAS f32x4*)(WR + d * 8), w1 = *(const LAS f32x4*)(WR + d * 8 + 4); const float x = v[j][k];
                    lgt[0] += x * w0[0]; lgt[1] += x * w0[1]; lgt[2] += x * w0[2]; lgt[3] += x * w0[3]; lgt[4] += x * w1[0]; lgt[5] += x * w1[1]; lgt[6] += x * w1[2]; lgt[7] += x * w1[3]; }
#pragma unroll
            for (int e = 0; e < NE; ++e) lgt[e] = wave_sum(lgt[e]);
            int i0 = 0; float v0 = lgt[0];
#pragma unroll
            for (int e = 1; e < NE; ++e) if (lgt[e] > v0) { v0 = lgt[e]; i0 = e; }
            int i1 = -1; float v1 = -INFINITY;
#pragma unroll
            for (int e = 0; e < NE; ++e) if (e != i0 && lgt[e] > v1) { v1 = lgt[e]; i1 = e; }
            const float g1 = 1.f / (1.f + __expf(v0 - v1)), g0 = 1.f - g1;
            if (lane == i) { me0 = i0; me1 = i1; mg0 = g0; mg1 = g1; }
        }
    }
    if (moe) {
        gu32* cnt = ((gu32*)(ws + WS_CTL)) + CW_CNT + jm * 8 * 64;
        const int oe1 = __builtin_amdgcn_ds_bpermute((lane & 15) << 2, me1);
        const bool valid = lane < 32; const int k = lane >> 4; const int mye = valid ? (k ? oe1 : me0) : -1;
        unsigned slot = 0;
#pragma unroll
        for (int e = 0; e < NE; ++e) { const unsigned long long mask = __ballot(mye == e); const unsigned c = (unsigned)__popcll(mask);
            unsigned wb = 0; if (lane == 0 && c) wb = __hip_atomic_fetch_add(lcnt + e, c, __ATOMIC_RELAXED, __HIP_MEMORY_SCOPE_WORKGROUP);
            wb = (unsigned)__builtin_amdgcn_readfirstlane((int)wb);
            if (mye == e) slot = wb + (unsigned)__popcll(mask & ((1ull << lane) - 1ull)); }
        __syncthreads();
        if (tid < NE) lcnt[8 + tid] = __hip_atomic_fetch_add(cnt + 64 * tid, lcnt[tid], RLX_AGENT);
        __syncthreads();
        if (valid) {
            slot += lcnt[8 + mye];
            const int row = gw * 16 + (lane & 15);
            ((unsigned*)(ws + WS_LIST))[(size_t)mye * M + slot] = (unsigned)row;
            ((unsigned*)(ws + WS_TOKS))[2 * row + k] = slot;
            if (k == 0) { ((unsigned*)(ws + WS_TOKE))[row] = (unsigned)me0 | ((unsigned)me1 << 8); ((float*)(ws + WS_TOKG))[2 * row] = mg0; ((float*)(ws + WS_TOKG))[2 * row + 1] = mg1; }
        }
    }
    const float* P = AIN(1) + (size_t)layer * M * DPLE + (size_t)gw * 16 * DPLE; bf16_t* PB = (bf16_t*)(ws + (DRY ? WS_ACT + 192 * MiB : WS_PBL)) + (size_t)gw * 16 * DPLE;
#pragma unroll 4
    for (int i = 0; i < 16; ++i) { const f32x4 x = *(const f32x4*)(P + i * 256 + 4 * lane); u32x2 w; w.x = cvt_pk_bf16(x[0], x[1]); w.y = cvt_pk_bf16(x[2], x[3]); *(u32x2*)(PB + i * 256 + 4 * lane) = w; }
}

struct MoeTiles { int cnt[NE]; int ts[NE + 1]; };
__device__ __forceinline__ void moe_tiles(unsigned char* ws, int jm, MoeTiles& T) {
    gu32* cnt = ((gu32*)(ws + WS_CTL)) + CW_CNT + jm * 8 * 64; int s = 0;
#pragma unroll
    for (int e = 0; e < NE; ++e) { const int c = __builtin_amdgcn_readfirstlane((int)__hip_atomic_load(cnt + 64 * e, RLX_AGENT)); T.cnt[e] = c; T.ts[e] = s; s += (c + 255) >> 8; }
    T.ts[NE] = s;
}

template <bool DRY = false> __device__ __forceinline__ void ph_ln2(const Frame& F, int layer) {
    PHASE_PREAMBLE();
    const bool moe = (layer & 1) != 0; const int jm = layer >> 1;
    float* H32 = (float*)(ws + WS_H32); bf16_t* HB = (bf16_t*)(ws + WS_HB); const bf16_t* Y = (const bf16_t*)(ws + WS_Y);
    MoeTiles T; if (moe) moe_tiles(ws, jm, T);
    f32x4 g[4], b[4];
#pragma unroll
    for (int j = 0; j < 4; ++j) { g[j] = *(const f32x4*)(AIN(25) + layer * D + 4 * lane + 256 * j); b[j] = *(const f32x4*)(AIN(26) + layer * D + 4 * lane + 256 * j); }
    const int gw = vcu * NWAVES + wave, NGW = F.G * NWAVES;
    for (int m = gw; m < M; m += NGW) {
        f32x4 v[4];
#pragma unroll
        for (int j = 0; j < 4; ++j) v[j] = *(const f32x4*)(H32 + (size_t)m * D + 4 * lane + 256 * j);
        if (moe) {
            const unsigned ee = ((const unsigned*)(ws + WS_TOKE))[m]; const int e0 = ee & 0xff, e1 = (ee >> 8) & 0xff;
            const unsigned s0 = ((const unsigned*)(ws + WS_TOKS))[2 * m], s1 = ((const unsigned*)(ws + WS_TOKS))[2 * m + 1];
            const float g0 = ((const float*)(ws + WS_TOKG))[2 * m], g1 = ((const float*)(ws + WS_TOKG))[2 * m + 1];
            int t0 = 0, t1 = 0;
#pragma unroll
            for (int e = 0; e < NE; ++e) { if (e == e0) t0 = T.ts[e]; if (e == e1) t1 = T.ts[e]; }
            const bf16_t* y0 = Y + ((size_t)t0 * 256 + s0) * D; const bf16_t* y1 = Y + ((size_t)t1 * 256 + s1) * D;
#pragma unroll
            for (int j = 0; j < 4; ++j) { const u32x2 p0 = *(const u32x2*)(y0 + 4 * lane + 256 * j), p1 = *(const u32x2*)(y1 + 4 * lane + 256 * j);
                v[j][0] += g0 * bf_lo(p0.x) + g1 * bf_lo(p1.x); v[j][1] += g0 * bf_hi(p0.x) + g1 * bf_hi(p1.x);
                v[j][2] += g0 * bf_lo(p0.y) + g1 * bf_lo(p1.y); v[j][3] += g0 * bf_hi(p0.y) + g1 * bf_hi(p1.y); }
        }
        ln_row(v, g, b);
        if (DRY) store_row(v, nullptr, (bf16_t*)(ws + WS_ACT + 128 * MiB) + (size_t)m * D, lane);
        else if (layer == DEPTH - 1) store_row(v, ((float*)(GAS float*)a->out) + (size_t)m * D, nullptr, lane);
        else store_row(v, nullptr, HB + (size_t)m * D, lane);
    }
}

__global__ void __launch_bounds__(NWAVES * 64, 2) mk_fwd(Args args) {
    extern __shared__ __attribute__((aligned(16))) unsigned char lds[];
    Frame F;
    F.lds = (LAS unsigned char*)lds;
    volatile LAS unsigned* MISC = (volatile LAS unsigned*)(F.lds + MISC_OFF);
    F.wave = __builtin_amdgcn_readfirstlane((int)(threadIdx.x >> 6));
    { const int bx = blockIdx.x; F.vcu = (bx % 8) * (GRID / 8) + bx / 8; }
    if (threadIdx.x < 64) MISC[threadIdx.x] = 0u;
    __syncthreads();
    const int lo = args.ph_lo, hi = args.ph_hi;
    XcdBarrier bar; bar.bar = (unsigned*)(args.ws + WS_CTL) + CW_BAR; bar.x = 0; bar.st = nullptr;
    if (hi - lo > 1) bar = xcd_barrier_post((unsigned*)(args.ws + WS_CTL) + CW_BAR, MISC + 8);
#define IN(k) (lo <= (k) && (k) < hi)
#define SEAM(k) do { if (IN(k) && IN((k) + 1)) xcd_barrier<__COUNTER__>(bar, F.wave * 64 + OPAQUE_LANE()); } while (0)
    const LAS unsigned short* tok = (const LAS unsigned short*)(F.lds + TOK_OFF);
    const int c = (int)blockIdx.x;

    if (IN(0)) { ph_prologue(F); if (PROBE_DUP & 1) { __syncthreads(); ph_prologue(F); } } SEAM(0);

    for (int layer = 0; layer < DEPTH; ++layer) {
        const int pb = 1 + layer * 7; const int jd = layer >> 1;
        if (IN(pb + 0)) {
            CArgs a = OPAQUE_ARGS(); unsigned char* const ws = (unsigned char*)(GAS unsigned char*)a->ws;
            pg8::DenseSched S; S.o.init(M / 256, DIN / 256, F.G, OPAQUE_S(c)); S.Bt = (const char*)(ws + WS_WIN) + (size_t)layer * DIN * D * 2; S.tstepB = (size_t)256 * D * 2;
            pg8::EpiProj E{(bf16_t*)(ws + WS_AG), (bf16_t*)(ws + WS_Q), (bf16_t*)(ws + WS_K), (bf16_t*)(ws + WS_V), AIN(5) + layer * DIN, QSCALE};
            pg8::gemm_phase<1>(F.lds, (const char*)(ws + WS_HB), D, S, E, tok, OPAQUE_S(F.wave));
        } SEAM(pb + 0);
        if (IN(pb + 1)) { ph_conv(F, layer); if (PROBE_DUP & 2) ph_conv(F, layer); ph_attn(F, layer); if (PROBE_DUP & 4) ph_attn(F, layer); } SEAM(pb + 1);
        if (IN(pb + 2)) {
            CArgs a = OPAQUE_ARGS(); unsigned char* const ws = (unsigned char*)(GAS unsigned char*)a->ws;
            pg8::DenseSched S; S.o.init(M / 256, D / 256, F.G, OPAQUE_S(c)); S.Bt = (const char*)(ws + WS_WOUT) + (size_t)layer * D * D * 2; S.tstepB = (size_t)256 * D * 2;
            pg8::EpiResid E{(float*)(ws + WS_H32), (const bf16_t*)(ws + WS_HB), AIN(12) + layer * D, ALPHA};
            pg8::gemm_phase<2>(F.lds, (const char*)(ws + WS_MIX), D, S, E, tok, OPAQUE_S(F.wave));
        } SEAM(pb + 2);
        if (IN(pb + 3)) { if (PROBE_DUP & 8) { ph_ln1<true>(F, layer); __syncthreads(); } ph_ln1(F, layer); if (layer == 2) { __syncthreads(); PHASE_PREAMBLE(); cvt_moe_weights(F, a, ws, lane, wave, vcu, 1); } } SEAM(pb + 3);
        if (IN(pb + 4)) {
            {   CArgs a = OPAQUE_ARGS(); unsigned char* const ws = (unsigned char*)(GAS unsigned char*)a->ws;
                pg8::DenseSched S; S.o.init(M / 256, D / 256, F.G, OPAQUE_S(c)); S.Bt = (const char*)(ws + WS_WP) + (size_t)layer * D * DPLE * 2; S.tstepB = (size_t)256 * DPLE * 2;
                pg8::EpiPE E{(bf16_t*)(ws + WS_PE)};
                pg8::gemm_phase<3>(F.lds, (const char*)(ws + WS_PBL), DPLE, S, E, tok, OPAQUE_S(F.wave)); }
            {   CArgs a = OPAQUE_ARGS(); unsigned char* const ws = (unsigned char*)(GAS unsigned char*)a->ws;
                pg8::DenseSched S; S.o.init(M / 256, D / 256, F.G, OPAQUE_S(c)); S.Bt = (const char*)(ws + WS_WG) + (size_t)layer * D * D * 2; S.tstepB = (size_t)256 * D * 2;
                pg8::EpiGate E{(float*)(ws + WS_H32), (const bf16_t*)(ws + WS_HB), (const bf16_t*)(ws + WS_PE), AIN(24) + layer * D, ALPHA};
                pg8::gemm_phase<4>(F.lds, (const char*)(ws + WS_HB), D, S, E, tok, OPAQUE_S(F.wave)); }
            if ((layer & 1) == 0) {
                CArgs a = OPAQUE_ARGS(); unsigned char* const ws = (unsigned char*)(GAS unsigned char*)a->ws;
                pg8::DenseSched S; S.o.init(M / 256, 2 * DFF / 256, F.G, OPAQUE_S(c)); S.Bt = (const char*)(ws + WS_W13) + (size_t)jd * 2 * DFF * D * 2; S.tstepB = (size_t)256 * D * 2;
                pg8::EpiSwiglu E{(bf16_t*)(ws + WS_ACT), DFF};
                pg8::gemm_phase<5>(F.lds, (const char*)(ws + WS_HB), D, S, E, tok, OPAQUE_S(F.wave));
            } else {
                PHASE_PREAMBLE();
                MoeTiles T; moe_tiles(ws, jd, T);
                pg8::MoeSched<true> S; S.o.init(T.ts[NE], 2 * DFE / 256, F.G, OPAQUE_S(c)); S.Bt = (const char*)(ws + WS_WM); S.tstepB = (size_t)256 * D * 2; S.estepB = WM13_E;
                S.t1 = T.ts[1]; S.t2 = T.ts[2]; S.t3 = T.ts[3]; S.t4 = T.ts[4]; S.t5 = T.ts[5]; S.t6 = T.ts[6]; S.t7 = T.ts[7];
                {   LAS unsigned short* tw = (LAS unsigned short*)(F.lds + TOK_OFF); const unsigned* list = (const unsigned*)(ws + WS_LIST); pg8::Unit u;
                    for (int i = 0; i < 32 && S.next(i, u); ++i) { const int e = S.expert(u.pm);
                        int ce = 0, te = 0;
#pragma unroll
                        for (int x = 0; x < NE; ++x) if (x == e) { ce = T.cnt[x]; te = T.ts[x]; }
                        if (tid < 256) { const int s = (u.pm - te) * 256 + tid; tw[i * 256 + tid] = (unsigned short)(s < ce ? list[(size_t)e * M + s] : 0u); } }
                    __syncthreads(); }
                pg8::EpiSwiglu E{(bf16_t*)(ws + WS_ACT), DFE};
                pg8::gemm_phase<6>(F.lds, (const char*)(ws + WS_HB), D, S, E, tok, OPAQUE_S(F.wave));
            }
        } SEAM(pb + 4);
        if (IN(pb + 5)) {
            if ((layer & 1) == 0) {
                CArgs a = OPAQUE_ARGS(); unsigned char* const ws = (unsigned char*)(GAS unsigned char*)a->ws;
                pg8::DenseSched S; S.o.init(M / 256, D / 256, F.G, OPAQUE_S(c)); S.Bt = (const char*)(ws + WS_W2) + (size_t)jd * D * DFF * 2; S.tstepB = (size_t)256 * DFF * 2;
                pg8::EpiResid E{(float*)(ws + WS_H32), nullptr, nullptr, 1.f};
                pg8::gemm_phase<7>(F.lds, (const char*)(ws + WS_ACT), DFF, S, E, tok, OPAQUE_S(F.wave));
            } else {
                CArgs a = OPAQUE_ARGS(); unsigned char* const ws = (unsigned char*)(GAS unsigned char*)a->ws;
                MoeTiles T; moe_tiles(ws, jd, T);
                pg8::MoeSched<false> S; S.o.init(T.ts[NE], D / 256, F.G, OPAQUE_S(c)); S.Bt = (const char*)(ws + WS_WM2); S.tstepB = (size_t)256 * DFE * 2; S.estepB = WM2_E;
                S.t1 = T.ts[1]; S.t2 = T.ts[2]; S.t3 = T.ts[3]; S.t4 = T.ts[4]; S.t5 = T.ts[5]; S.t6 = T.ts[6]; S.t7 = T.ts[7];
                pg8::EpiBf16 E{(bf16_t*)(ws + WS_Y), D};
                pg8::gemm_phase<8>(F.lds, (const char*)(ws + WS_ACT), DFE, S, E, tok, OPAQUE_S(F.wave));
            }
        } SEAM(pb + 5);
        if (IN(pb + 6)) { if (PROBE_DUP & 16) ph_ln2<true>(F, layer); ph_ln2(F, layer); } SEAM(pb + 6);
    }
#undef IN
#undef SEAM
}

extern "C" void kernel_launch(void* const* d_in, const int* in_sizes, int n_in, void* d_out, int out_size, void* d_ws, size_t ws_size, hipStream_t stream) {
    static int grid = 0;
    if (grid == 0) {
        if (n_in != 27 || out_size != M * D || ws_size < WS_END) { fprintf(stderr, "kernel_launch: unexpected problem (n_in %d, out %d, ws %zu < %zu)\n", n_in, out_size, ws_size, (size_t)WS_END); grid = -1; return; }
        int dev = 0, cus = 0, per_cu = 0;
        if (hipGetDevice(&dev) != hipSuccess || hipDeviceGetAttribute(&cus, hipDeviceAttributeMultiprocessorCount, dev) != hipSuccess) { grid = -1; return; }
        if (hipFuncSetAttribute((const void*)mk_fwd, hipFuncAttributeMaxDynamicSharedMemorySize, LDS_BYTES) != hipSuccess) { fprintf(stderr, "kernel_launch: hipFuncSetAttribute failed\n"); grid = -1; return; }
        if (hipOccupancyMaxActiveBlocksPerMultiprocessor(&per_cu, (const void*)mk_fwd, NWAVES * 64, LDS_BYTES) != hipSuccess || per_cu < 1) fprintf(stderr, "kernel_launch: occupancy query says %d\n", per_cu);
        (void)hipGetLastError();
        if (cus < GRID) { fprintf(stderr, "kernel_launch: %d CUs; built for %d\n", cus, GRID); grid = -1; return; }
        grid = GRID;
    }
    if (grid < 0) return;
    if (hipMemsetAsync((char*)d_ws + WS_CTL, 0, CTL_ZERO_BYTES, stream) != hipSuccess) return;
    Args a{};
    for (int i = 0; i < 27; ++i) a.in[i] = (const float*)d_in[i];
    a.out = (float*)d_out; a.ws = (unsigned char*)d_ws;
#if MK_MULTI
    for (int ph = 0; ph < NPH; ++ph) { a.ph_lo = ph; a.ph_hi = ph + 1; hipLaunchKernelGGL(mk_fwd, dim3(grid), dim3(NWAVES * 64), LDS_BYTES, stream, a); }
#else
    a.ph_lo = 0; a.ph_hi = NPH; hipLaunchKernelGGL(mk_fwd, dim3(grid), dim3(NWAVES * 64), LDS_BYTES, stream, a);
#endif
}
```
